# Optimizing an MI355X kernel written in HIP

```python
import math
import jax, jax.numpy as jnp
from jax import lax
import numpy as np

D_MODEL = 1024
BATCH = 2
SEQ = 8192
DEPTH = 2

D_MIX = D_MODEL
N_HEADS_A = 8
HEAD_DIM_A = 64
D_A = N_HEADS_A * HEAD_DIM_A
KV_RANK = 128
N_IDX_HEADS = 8
IDX_DIM = 32
TOPK_MAX = 256
Q_BLOCK = 128
N_POOL_GROUPS = 4
POOL_GROUP_DIM = 64
D_B = N_POOL_GROUPS * POOL_GROUP_DIM
POOL_WINDOWS = (2, 4, 8, 16)
D_C = D_MIX - D_A - D_B
CONV_WIDTH = 31
COL_Q = D_A
COL_KV = COL_Q + KV_RANK
COL_IQ = COL_KV + N_IDX_HEADS * IDX_DIM
COL_IK = COL_IQ + IDX_DIM
COL_IW = COL_IK + N_IDX_HEADS
COL_POOL = COL_IW + D_B
D_IN = COL_POOL + 2 * D_C
SPLIT_POINTS = (COL_Q, COL_KV, COL_IQ, COL_IK, COL_IW, COL_POOL)
N_EXPERTS = 16
N_EXPERT_GROUPS = 4
EXPERTS_PER_GROUP = N_EXPERTS // N_EXPERT_GROUPS
TOP_K = 2
D_EXPERT = 512
MOE_CHUNK = 2048
ALPHA = (2 * DEPTH) ** 0.25
BETA = (8 * DEPTH) ** -0.25
LN_EPS = 1e-5

kernel_name = "hymba_dsa_pool_conformer_groupmoe_deepnorm"


def layer_norm(x, g, b):
    xf = x.astype(jnp.float32)
    mu = jnp.mean(xf, axis=-1, keepdims=True)
    var = jnp.mean(jnp.square(xf - mu), axis=-1, keepdims=True)
    return ((xf - mu) * lax.rsqrt(var + LN_EPS) * g.astype(jnp.float32) + b.astype(jnp.float32)).astype(x.dtype)


def rms_norm(x, g):
    xf = x.astype(jnp.float32)
    ms = jnp.mean(jnp.square(xf), axis=-1, keepdims=True)
    return (xf * lax.rsqrt(ms + LN_EPS) * g.astype(jnp.float32)).astype(x.dtype)


def dsa_attention(q, c_kv, iq, ik, iw, w_uk, w_uv):
    B, S = q.shape[0], q.shape[1]
    topk = min(TOPK_MAX, S // 4)
    nb = S // Q_BLOCK
    q_lat = jnp.einsum('bshd,hrd->bshr', q, w_uk) * (HEAD_DIM_A ** -0.5)
    key_pos = jnp.arange(S)

    def to_blocks(a):
        return a.reshape((B, nb, Q_BLOCK) + a.shape[2:]).swapaxes(0, 1)

    def block_fn(args):
        blk, q_b, iq_b, iw_b = args
        q_pos = blk * Q_BLOCK + jnp.arange(Q_BLOCK)
        logits = jnp.einsum('bqhd,bsd->bqhs', iq_b, ik).astype(jnp.float32)
        idx_score = jnp.einsum('bqhs,bqh->bqs', jax.nn.relu(logits), iw_b.astype(jnp.float32))
        causal = key_pos[None, :] <= q_pos[:, None]
        idx_score = jnp.where(causal[None], idx_score, -jnp.inf)
        _, sel = lax.top_k(idx_score, topk)
        c_sel = jax.vmap(lambda c, i: c[i])(c_kv, sel)
        s = jnp.einsum('bqhr,bqkr->bqhk', q_b, c_sel).astype(jnp.float32)
        valid = sel <= q_pos[None, :, None]
        s = jnp.where(valid[:, :, None, :], s, -jnp.inf)
        p = jax.nn.softmax(s, axis=-1).astype(c_sel.dtype)
        return jnp.einsum('bqhk,bqkr->bqhr', p, c_sel)

    o_lat = lax.map(block_fn, (jnp.arange(nb), to_blocks(q_lat), to_blocks(iq), to_blocks(iw)))
    o_lat = o_lat.swapaxes(0, 1).reshape(B, S, N_HEADS_A, KV_RANK)
    o = jnp.einsum('bshr,hrd->bshd', o_lat, w_uv)
    return o.reshape(B, S, D_A)


def multi_scale_pool(u, w_pool, scale):
    B, S = u.shape[0], u.shape[1]
    ug = u.reshape(B, S, N_POOL_GROUPS, POOL_GROUP_DIM).astype(jnp.float32)
    cs = jnp.cumsum(ug, axis=1)
    t = jnp.arange(1, S + 1, dtype=jnp.float32)
    outs = []
    for gi, w in enumerate(POOL_WINDOWS):
        c = cs[:, :, gi]
        prev = jnp.pad(c, ((0, 0), (w, 0), (0, 0)))[:, :S]
        cnt = jnp.minimum(t, float(w))[None, :, None]
        outs.append((c - prev) / cnt - ug[:, :, gi])
    pooled = jnp.stack(outs, axis=2).astype(u.dtype)
    y = jnp.einsum('bsgc,gcd->bsgd', pooled, w_pool)
    return y.reshape(B, S, D_B) * scale


def conformer_conv(u, conv_w, conv_b, ln_g, ln_b):
    a, gate = jnp.split(u, 2, axis=-1)
    h = a * jax.nn.sigmoid(gate)
    h = lax.conv_general_dilated(h, conv_w, window_strides=(1,), padding=[(CONV_WIDTH - 1, 0)],
                                 dimension_numbers=('NWC', 'WIO', 'NWC'),
                                 feature_group_count=D_C) + conv_b
    h = layer_norm(h, ln_g, ln_b)
    return jax.nn.silu(h)


def grouped_moe(x, router_w, router_bias, w_gate, w_up, w_down):
    B, S, D = x.shape
    N = B * S
    xt = x.reshape(N, D)
    aff = jax.nn.sigmoid(jnp.dot(xt, router_w).astype(jnp.float32))
    sel_score = aff + router_bias.astype(jnp.float32)
    grp_score = lax.top_k(sel_score.reshape(N, N_EXPERT_GROUPS, EXPERTS_PER_GROUP), TOP_K)[0].sum(-1)
    best = jnp.argmax(grp_score, axis=-1)
    in_group = (jnp.arange(N_EXPERTS) // EXPERTS_PER_GROUP)[None, :] == best[:, None]
    _, top_idx = lax.top_k(jnp.where(in_group, sel_score, -jnp.inf), TOP_K)
    top_aff = jnp.take_along_axis(aff, top_idx, axis=-1)
    gates_k = top_aff / jnp.sum(top_aff, axis=-1, keepdims=True)
    gates = jnp.sum(jax.nn.one_hot(top_idx, N_EXPERTS, dtype=jnp.float32) * gates_k[..., None], axis=1)
    chunk = math.gcd(N, MOE_CHUNK)

    def chunk_fn(args):
        xc, gc = args
        h = jax.nn.silu(jnp.einsum('cd,edf->cef', xc, w_gate)) * jnp.einsum('cd,edf->cef', xc, w_up)
        h = h * gc[:, :, None].astype(h.dtype)
        return jnp.einsum('cef,efd->cd', h, w_down)

    y = lax.map(chunk_fn, (xt.reshape(-1, chunk, D), gates.reshape(-1, chunk, N_EXPERTS)))
    return y.reshape(B, S, D)


def setup_inputs(seed: int = 0) -> dict:
    key = jax.random.key(seed)
    ks = jax.random.split(key, 24)
    L = DEPTH
    nrm = lambda k, shape, s: jax.random.normal(k, shape, jnp.float32) * s
    return {
        "x": nrm(ks[0], (BATCH, SEQ, D_MODEL), 1.0),
        "w_in": nrm(ks[1], (L, D_MODEL, D_IN), D_MODEL ** -0.5),
        "kv_norm_g": 1.0 + nrm(ks[2], (L, KV_RANK), 0.02),
        "w_uk": nrm(ks[3], (L, N_HEADS_A, KV_RANK, HEAD_DIM_A), KV_RANK ** -0.5),
        "w_uv": nrm(ks[4], (L, N_HEADS_A, KV_RANK, HEAD_DIM_A), KV_RANK ** -0.5),
        "w_pool": nrm(ks[5], (L, N_POOL_GROUPS, POOL_GROUP_DIM, POOL_GROUP_DIM), POOL_GROUP_DIM ** -0.5),
        "pool_scale": 1.0 + nrm(ks[6], (L, D_B), 0.02),
        "conv_w": nrm(ks[7], (L, CONV_WIDTH, 1, D_C), CONV_WIDTH ** -0.5),
        "conv_b": nrm(ks[8], (L, D_C), 0.02),
        "conv_ln_g": 1.0 + nrm(ks[9], (L, D_C), 0.02),
        "conv_ln_b": nrm(ks[10], (L, D_C), 0.02),
        "w_o": nrm(ks[11], (L, D_MIX, D_MODEL), BETA * D_MIX ** -0.5),
        "ln1_g": 1.0 + nrm(ks[12], (L, D_MODEL), 0.02),
        "ln1_b": nrm(ks[13], (L, D_MODEL), 0.02),
        "router_w": nrm(ks[14], (D_MODEL, N_EXPERTS), D_MODEL ** -0.5),
        "router_bias": nrm(ks[15], (N_EXPERTS,), 0.01),
        "w_gate": nrm(ks[16], (L, N_EXPERTS, D_MODEL, D_EXPERT), D_MODEL ** -0.5),
        "w_up": nrm(ks[17], (L, N_EXPERTS, D_MODEL, D_EXPERT), D_MODEL ** -0.5),
        "w_down": nrm(ks[18], (L, N_EXPERTS, D_EXPERT, D_MODEL), BETA * D_EXPERT ** -0.5),
        "ln2_g": 1.0 + nrm(ks[19], (L, D_MODEL), 0.02),
        "ln2_b": nrm(ks[20], (L, D_MODEL), 0.02),
    }


def reference(x, w_in, kv_norm_g, w_uk, w_uv, w_pool, pool_scale, conv_w, conv_b, conv_ln_g,
              conv_ln_b, w_o, ln1_g, ln1_b, router_w, router_bias, w_gate, w_up, w_down,
              ln2_g, ln2_b):
    B, S = x.shape[0], x.shape[1]
    for l in range(DEPTH):
        proj = jnp.einsum('bsd,de->bse', x, w_in[l])
        q, c_kv, iq, ik, iw, u_pool, u_conv = jnp.split(proj, SPLIT_POINTS, axis=-1)
        q = q.reshape(B, S, N_HEADS_A, HEAD_DIM_A)
        c_kv = rms_norm(c_kv, kv_norm_g[l])
        iq = iq.reshape(B, S, N_IDX_HEADS, IDX_DIM) * (IDX_DIM ** -0.5)
        iw = iw * (N_IDX_HEADS ** -0.5)
        y_a = dsa_attention(q, c_kv, iq, ik, iw, w_uk[l], w_uv[l])
        y_b = multi_scale_pool(u_pool, w_pool[l], pool_scale[l])
        y_c = conformer_conv(u_conv, conv_w[l], conv_b[l], conv_ln_g[l], conv_ln_b[l])
        mix = jnp.einsum('bse,ed->bsd', jnp.concatenate([y_a, y_b, y_c], axis=-1), w_o[l])
        x = layer_norm(ALPHA * x + mix, ln1_g[l], ln1_b[l])
        ffn = grouped_moe(x, router_w, router_bias, w_gate[l], w_up[l], w_down[l])
        x = layer_norm(ALPHA * x + ffn, ln2_g[l], ln2_b[l])
    return x
```

```cpp
#include <hip/hip_runtime.h>
#include <hip/hip_cooperative_groups.h>
#include <cstdio>
#include <cstdint>
namespace cg = cooperative_groups;
namespace pg8 {
#define PG8_LAS __attribute__((address_space(3)))
typedef unsigned short bf16_t;
typedef short bf16x8 __attribute__((ext_vector_type(8)));
typedef float f32x4 __attribute__((ext_vector_type(4)));
typedef unsigned u32x4 __attribute__((ext_vector_type(4)));
constexpr int BM = 256, BK = 64, HALF = 128, HTB = HALF * BK * 2  , STAGE_BYTES = 8 * HTB, NXCD = 8, WGM = 8;

__host__ __device__ __forceinline__ int lds_byte(int r, int c) { const int st = (r >> 4) * 2 + (c >> 5), rr = r & 15, cc = c & 31, ob = rr * 64 + cc * 2; return st * 1024 + (ob ^ (((ob >> 9) & 1) << 5)); }
__host__ __device__ __forceinline__ void stage_rc(int b, int& R, int& C) { const int st = b / 1024, sb = b % 1024, swz = sb ^ (((sb >> 9) & 1) << 5); R = (st >> 1) * 16 + swz / 64; C = (st & 1) * 32 + (swz % 64) / 2; }
__host__ __device__ __forceinline__ int perm32(int rho) { const int n = rho >> 4, i = rho & 15; return 8 * (i >> 2) + 4 * n + (i & 3); }

struct Unit { int pm, pn; };
struct Gemm { const bf16_t* A; const bf16_t* Bt; int M, N, K; };

struct StaticOrder {
    int nM, nN, nwg, G, c;
    __host__ __device__ void init(int M, int N, int G_, int c_) { nM = M / BM; nN = N / BM; nwg = nM * nN; G = G_; c = c_; }
    __host__ __device__ bool next(int i, Unit& u) const {
        const long L = (long)i * G + c; if (L >= nwg) return false;
        int wgid = (int)L; { const int q = nwg / NXCD, r = nwg % NXCD, xcd = wgid % NXCD, off = wgid / NXCD; wgid = (xcd < r ? xcd * (q + 1) : r * (q + 1) + (xcd - r) * q) + off; }
        const int nig = WGM * nN, gid = wgid / nig, fm = gid * WGM, gsz = (nM - fm) < WGM ? (nM - fm) : WGM;
        u.pm = fm + ((wgid % nig) % gsz); u.pn = (wgid % nig) / gsz; return true;
    }
    __device__ __forceinline__ void a_ready(const Unit&) const {}
    __device__ __forceinline__ void done(const Unit&) const {}
};

template <class Epi, class Sched, bool ALIGN_EPI = false, bool SP2 = false>
__device__ __forceinline__ void gemm_phase(PG8_LAS unsigned char* lds, const Gemm g, const Sched& S, const Epi& E) {
    int tid_ = threadIdx.x; asm volatile("" : "+v"(tid_));
    const int tid = tid_, wid = __builtin_amdgcn_readfirstlane(tid >> 6), lane = tid & 63, wr = wid >> 2, wc = wid & 3, fr = lane & 15, fq = lane >> 4;
    const int K = g.K, nt = K / BK;
    unsigned voffA[2], voffB[2];
#pragma unroll
    for (int i = 0; i < 2; ++i) { int R, C; stage_rc(tid * 16 + i * 8192, R, C); const int Rb = Epi::PERM ? ((R & ~31) + perm32(R & 31)) : R;
        voffA[i] = (unsigned)(R * K + C) * 2u; voffB[i] = (unsigned)(Rb * K + C) * 2u; }
    const size_t kstep = (size_t)(BK * 2);
    const size_t hstep = (size_t)HALF * K * 2;
    const size_t tstep = 2 * hstep;
    const unsigned ldsw = (unsigned)wid * 1024u;
    const int aoff = lds_byte(wr * 64 + fr, fq * 8), boff = lds_byte(wc * 32 + fr, fq * 8);
#define PG8_SA(b, h) (((b) * 2 + (h)) * HTB)
#define PG8_SB(b, h) ((4 + (b) * 2 + (h)) * HTB)
#define PG8_STAGE(bufoff, gbase, voff) do { _Pragma("unroll") for (int _i = 0; _i < 2; ++_i) \
        __builtin_amdgcn_global_load_lds((const unsigned*)((const char*)(gbase) + (voff)[_i]), (PG8_LAS unsigned*)(lds + (bufoff) + ldsw + _i * 8192), 16, 0, 0); } while (0)
#define PG8_LDA(dst, b, h) do { _Pragma("unroll") for (int m = 0; m < 4; ++m) _Pragma("unroll") for (int k = 0; k < 2; ++k) dst[m][k] = *(const PG8_LAS bf16x8*)(lds + PG8_SA(b, h) + aoff + m * 2048 + k * 1024); } while (0)
#define PG8_LDB(dst, b, h) do { _Pragma("unroll") for (int n = 0; n < 2; ++n) _Pragma("unroll") for (int k = 0; k < 2; ++k) dst[n][k] = *(const PG8_LAS bf16x8*)(lds + PG8_SB(b, h) + boff + n * 2048 + k * 1024); } while (0)
#define PG8_MMA(ai, bj, At, Bt) do { __builtin_amdgcn_s_setprio(1); _Pragma("unroll") for (int m = 0; m < 4; ++m) _Pragma("unroll") for (int n = 0; n < 2; ++n) _Pragma("unroll") for (int k = 0; k < 2; ++k) \
        acc[ai][bj][m][n] = __builtin_amdgcn_mfma_f32_16x16x32_bf16(Bt[n][k], At[m][k], acc[ai][bj][m][n], 0, 0, 0); __builtin_amdgcn_s_setprio(0); } while (0)
#define PG8_WAIT_V(n) asm volatile("s_waitcnt vmcnt(" #n ")" ::: "memory")
#define PG8_WAIT_L(n) asm volatile("s_waitcnt lgkmcnt(" #n ")" ::: "memory")
#define PG8_BAR __builtin_amdgcn_s_barrier()
#define PG8_SCHED __builtin_amdgcn_sched_barrier(0)
    Unit cur, nxt; int ui = 0;
    if (!S.next(0, cur)) return;
    f32x4 acc[2][2][4][2];
#pragma unroll
    for (int a = 0; a < 2; ++a)
#pragma unroll
        for (int b = 0; b < 2; ++b)
#pragma unroll
            for (int m = 0; m < 4; ++m)
#pragma unroll
                for (int n = 0; n < 2; ++n) acc[a][b][m][n] = (f32x4){0.f, 0.f, 0.f, 0.f};
    bf16x8 At[4][2], B0[2][2], B1[2][2];
    const char* cA = (const char*)g.A + (size_t)cur.pm * tstep; const char* cB = (const char*)g.Bt + (size_t)cur.pn * tstep;
    S.a_ready(cur);
    if constexpr (SP2) {
        PG8_STAGE(PG8_SB(0, 0), cB, voffB); PG8_STAGE(PG8_SB(0, 1), cB + hstep, voffB); PG8_STAGE(PG8_SA(0, 0), cA, voffA); PG8_STAGE(PG8_SA(0, 1), cA + hstep, voffA);
        if (wr == 1) PG8_BAR;
        PG8_WAIT_V(2); PG8_BAR;
        PG8_STAGE(PG8_SB(1, 0), cB + kstep, voffB); PG8_STAGE(PG8_SA(1, 0), cA + kstep, voffA); PG8_STAGE(PG8_SB(1, 1), cB + hstep + kstep, voffB);
        PG8_WAIT_V(6); PG8_BAR;
    } else {
        PG8_STAGE(PG8_SB(0, 0), cB, voffB); PG8_STAGE(PG8_SA(0, 0), cA, voffA); PG8_STAGE(PG8_SB(0, 1), cB + hstep, voffB); PG8_STAGE(PG8_SA(0, 1), cA + hstep, voffA);
        if (wr == 1) PG8_BAR;
        PG8_WAIT_V(4); PG8_BAR;
        PG8_STAGE(PG8_SB(1, 0), cB + kstep, voffB); PG8_STAGE(PG8_SA(1, 0), cA + kstep, voffA); PG8_STAGE(PG8_SB(1, 1), cB + hstep + kstep, voffB);
        PG8_WAIT_V(6); PG8_BAR;
    }
    for (;;) {
        const bool has_next = S.next(ui + 1, nxt);
        const char* nA = has_next ? (const char*)g.A + (size_t)nxt.pm * tstep : cA; const char* nB = has_next ? (const char*)g.Bt + (size_t)nxt.pn * tstep : cB;
        for (int t = 0; t < nt; t += 2) {
            const bool last = (t == nt - 2);
            const char* a1 = cA + (size_t)(t + 1) * kstep;
            const char* a2 = last ? nA : cA + (size_t)(t + 2) * kstep; const char* b2 = last ? nB : cB + (size_t)(t + 2) * kstep;
            const char* a3 = a2 + kstep; const char* b3 = b2 + kstep;
            if (last && has_next) S.a_ready(nxt);
            if constexpr (SP2) {
            PG8_LDB(B0, 0, 0); PG8_LDB(B1, 0, 1); PG8_SCHED; PG8_LDA(At, 0, 0); PG8_STAGE(PG8_SA(1, 1), a1 + hstep, voffA);
            PG8_WAIT_V(8); PG8_WAIT_L(0); PG8_BAR; PG8_MMA(0, 0, At, B0); PG8_MMA(0, 1, At, B1); PG8_BAR; PG8_SCHED;
            PG8_LDA(At, 0, 1); PG8_STAGE(PG8_SB(0, 0), b2, voffB); PG8_STAGE(PG8_SB(0, 1), b2 + hstep, voffB); PG8_STAGE(PG8_SA(0, 0), a2, voffA);
            PG8_WAIT_V(8); PG8_WAIT_L(0); PG8_BAR; PG8_MMA(1, 0, At, B0); PG8_MMA(1, 1, At, B1); PG8_BAR; PG8_SCHED;
            PG8_LDB(B0, 1, 0); PG8_LDB(B1, 1, 1); PG8_SCHED; PG8_LDA(At, 1, 0); PG8_STAGE(PG8_SA(0, 1), a2 + hstep, voffA);
            PG8_WAIT_V(8); PG8_WAIT_L(0); PG8_BAR; PG8_MMA(0, 0, At, B0); PG8_MMA(0, 1, At, B1); PG8_BAR; PG8_SCHED;
            PG8_LDA(At, 1, 1); PG8_STAGE(PG8_SB(1, 0), b3, voffB); PG8_STAGE(PG8_SB(1, 1), b3 + hstep, voffB); PG8_STAGE(PG8_SA(1, 0), a3, voffA);
            PG8_WAIT_V(8); PG8_WAIT_L(0); PG8_BAR; PG8_MMA(1, 0, At, B0); PG8_MMA(1, 1, At, B1); PG8_BAR; PG8_SCHED;
            } else {
            PG8_LDB(B0, 0, 0); PG8_SCHED; PG8_LDA(At, 0, 0); PG8_STAGE(PG8_SA(1, 1), a1 + hstep, voffA);
            PG8_WAIT_L(8); PG8_BAR; PG8_WAIT_L(0); PG8_MMA(0, 0, At, B0); PG8_BAR; PG8_SCHED;
            PG8_LDB(B1, 0, 1); PG8_STAGE(PG8_SB(0, 0), b2, voffB);
            PG8_BAR; PG8_WAIT_L(0); PG8_MMA(0, 1, At, B1); PG8_BAR;
            PG8_LDA(At, 0, 1); PG8_STAGE(PG8_SA(0, 0), a2, voffA);
            PG8_BAR; PG8_WAIT_L(0); PG8_MMA(1, 0, At, B0); PG8_BAR; PG8_SCHED;
            PG8_STAGE(PG8_SB(0, 1), b2 + hstep, voffB);
            PG8_WAIT_V(6); PG8_BAR; PG8_MMA(1, 1, At, B1); PG8_BAR;
            PG8_LDB(B0, 1, 0); PG8_SCHED; PG8_LDA(At, 1, 0); PG8_STAGE(PG8_SA(0, 1), a2 + hstep, voffA);
            PG8_WAIT_L(8); PG8_BAR; PG8_WAIT_L(0); PG8_MMA(0, 0, At, B0); PG8_BAR; PG8_SCHED;
            PG8_LDB(B1, 1, 1); PG8_STAGE(PG8_SB(1, 0), b3, voffB);
            PG8_BAR; PG8_WAIT_L(0); PG8_MMA(0, 1, At, B1); PG8_BAR;
            PG8_LDA(At, 1, 1); PG8_STAGE(PG8_SA(1, 0), a3, voffA);
            PG8_BAR; PG8_WAIT_L(0); PG8_MMA(1, 0, At, B0); PG8_BAR; PG8_SCHED;
            PG8_STAGE(PG8_SB(1, 1), b3 + hstep, voffB);
            PG8_WAIT_V(6); PG8_BAR; PG8_MMA(1, 1, At, B1); PG8_BAR;
            }
        }
        if constexpr (ALIGN_EPI) { if (wr == 0) PG8_BAR; }
        if constexpr (!Epi::AFTER_DRAIN) { E(acc, cur, wr, wc, fr, fq); S.done(cur); }
        if (!has_next) break;
#pragma unroll
        for (int a = 0; a < 2; ++a)
#pragma unroll
            for (int b = 0; b < 2; ++b)
#pragma unroll
                for (int m = 0; m < 4; ++m)
#pragma unroll
                    for (int n = 0; n < 2; ++n) acc[a][b][m][n] = (f32x4){0.f, 0.f, 0.f, 0.f};
        cur = nxt; cA = nA; cB = nB; ++ui;
        if constexpr (ALIGN_EPI) { if (wr == 1) PG8_BAR; }
    }
    PG8_WAIT_V(0);
    if constexpr (!ALIGN_EPI) { if (wr == 0) PG8_BAR; }
    PG8_BAR;
    if constexpr (Epi::AFTER_DRAIN) { E.fused(acc, cur, wr, wc, fr, fq, lds, wid, lane); S.done(cur); }
#undef PG8_SA
#undef PG8_SB
#undef PG8_STAGE
#undef PG8_LDA
#undef PG8_LDB
#undef PG8_MMA
#undef PG8_WAIT_V
#undef PG8_WAIT_L
#undef PG8_BAR
#undef PG8_SCHED
}
}

#define LAS __attribute__((address_space(3)))
typedef unsigned short bf16_t;
typedef unsigned v4u __attribute__((ext_vector_type(4)));
typedef unsigned v2u __attribute__((ext_vector_type(2)));
typedef float f32x4 __attribute__((ext_vector_type(4)));
typedef float f32x16 __attribute__((ext_vector_type(16)));
typedef short bf16x8 __attribute__((ext_vector_type(8)));
typedef short s16x4 __attribute__((ext_vector_type(4)));

constexpr int NWAVES = 8, NTHR = 512;
constexpr int BATCH = 2, SEQ = 8192, DM = 1024, M = BATCH * SEQ;
constexpr int DIN = 1704;
constexpr int NPROJ = 2304;
constexpr int C_QL = 0, C_CKV = 1024, C_IQ = 1152, C_IK = 1408, C_IW = 1440, C_UP = 1448, C_UC = 1704, C_END = 2216;
constexpr int KMIX = 1536;
constexpr int NE = 16, DE = 512;
constexpr int MAXSLOT = 36864;
constexpr float ALPHA = 1.41421356237309515f, LN_EPS = 1e-5f;
constexpr int TOPK = 256;

constexpr size_t MiB = 1u << 20;
constexpr size_t WS_BLKCNT = 0;
constexpr size_t WS_TILETAB = 64 * 1024;
constexpr size_t WS_SSQ = 1 * MiB;
constexpr size_t WS_TOKE = 2 * MiB;
constexpr size_t WS_TOKG = 2 * MiB + 256 * 1024;
constexpr size_t WS_TOKS = 2 * MiB + 512 * 1024;
constexpr size_t WS_GSLOT = 3 * MiB;
constexpr size_t WS_WIN = 4 * MiB;
constexpr size_t WS_WO = 9 * MiB;
constexpr size_t WS_WGU = 12 * MiB;
constexpr size_t WS_WD = 44 * MiB;
constexpr size_t WS_XB = 60 * MiB;
constexpr size_t WS_R = 92 * MiB;
constexpr size_t WS_PROJ = WS_R;
constexpr size_t WS_YMIX = WS_R + 72 * MiB;
constexpr size_t WS_XS = WS_R;
constexpr size_t WS_H = WS_R + 72 * MiB;
constexpr size_t WS_END = WS_R + 120 * MiB;

constexpr int LDS_BYTES = 147456;
constexpr int LDS_MISC = 131072;

#define LDS_WAIT() asm volatile("s_waitcnt lgkmcnt(0)" ::: "memory")
#define VM_WAIT() asm volatile("s_waitcnt vmcnt(0)" ::: "memory")

__device__ __forceinline__ unsigned f2bf(float f) { unsigned u = __builtin_bit_cast(unsigned, f); return (u + 0x7fffu + ((u >> 16) & 1u)) >> 16; }
__device__ __forceinline__ unsigned pk2(float lo, float hi) { return f2bf(lo) | (f2bf(hi) << 16); }
__device__ __forceinline__ float bflo(unsigned w) { return __builtin_bit_cast(float, w << 16); }
__device__ __forceinline__ float bfhi(unsigned w) { return __builtin_bit_cast(float, w & 0xffff0000u); }
__device__ __forceinline__ float bf2f(bf16_t v) { return __builtin_bit_cast(float, (unsigned)v << 16); }
__device__ __forceinline__ int ld_agent(const int* p) { return __hip_atomic_load(p, __ATOMIC_RELAXED, __HIP_MEMORY_SCOPE_AGENT); }
__device__ __forceinline__ float ld_agent_f(const float* p) { return __hip_atomic_load(p, __ATOMIC_RELAXED, __HIP_MEMORY_SCOPE_AGENT); }
__device__ __forceinline__ float wave_sum(float v) {
#pragma unroll
    for (int o = 1; o < 64; o <<= 1) v += __shfl_xor(v, o);
    return v;
}
__device__ __forceinline__ float sigmoidf_(float x) { return 1.0f / (1.0f + __expf(-x)); }

struct Args {
    const float* in[21]; float* out; unsigned char* ws; int ph_lo, ph_hi, coop, pad;
};

struct Frame {
    LAS unsigned char* lds;
    int tid, lane, wave, G, bid;
};
__device__ __forceinline__ Frame relaunder(const Frame& F) { Frame L = F; int t = threadIdx.x; asm volatile("" : "+v"(t)); L.tid = t; L.lane = t & 63; L.wave = __builtin_amdgcn_readfirstlane(t >> 6); return L; }
typedef const __attribute__((address_space(4))) Args* KArgs;
__device__ __forceinline__ KArgs kargs() { KArgs p = (KArgs)__builtin_amdgcn_kernarg_segment_ptr(); asm volatile("" : "+s"(p)); return p; }
struct LayerW {
    const float *w_in, *kvg, *w_uk, *w_uv, *w_o, *w_gate, *w_up, *w_down;
};
__device__ __forceinline__ bf16_t* ws_bf(KArgs A, size_t off) { return (bf16_t*)(A->ws + off); }

struct EpiProj {
    static constexpr bool PERM = false, AFTER_DRAIN = false;
    bf16_t* O; float* ssq;
    __device__ __forceinline__ void operator()(const f32x4 (&acc)[2][2][4][2], const pg8::Unit& u, int wr, int wc, int fr, int fq) const {
        const int col0 = u.pn * 256 + wc * 32 + 4 * fq;
#pragma unroll
        for (int ai = 0; ai < 2; ++ai)
#pragma unroll
            for (int m = 0; m < 4; ++m) {
                const int row = u.pm * 256 + ai * 128 + wr * 64 + m * 16 + fr;
                bf16_t* rowp = O + (size_t)row * NPROJ + col0;
#pragma unroll
                for (int bj = 0; bj < 2; ++bj)
#pragma unroll
                    for (int n = 0; n < 2; ++n) { const f32x4 v = acc[ai][bj][m][n]; v2u w; w.x = pk2(v[0], v[1]); w.y = pk2(v[2], v[3]); *(v2u*)(rowp + bj * 128 + n * 16) = w; }
                if (u.pn == 4) {
                    float ss = 0.f;
#pragma unroll
                    for (int n = 0; n < 2; ++n) { const f32x4 v = acc[ai][0][m][n]; ss += (v[0] * v[0] + v[1] * v[1]) + (v[2] * v[2] + v[3] * v[3]); }
                    ss += __shfl_xor(ss, 16); ss += __shfl_xor(ss, 32);
                    if (fq == 0) ssq[(size_t)row * 4 + wc] = ss;
                }
            }
    }
};
struct EpiMix {
    static constexpr bool PERM = false, AFTER_DRAIN = false;
    const float* base; float* out;
    __device__ __forceinline__ void operator()(const f32x4 (&acc)[2][2][4][2], const pg8::Unit& u, int wr, int wc, int fr, int fq) const {
        const int col0 = u.pn * 256 + wc * 32 + 4 * fq;
#pragma unroll
        for (int ai = 0; ai < 2; ++ai)
#pragma unroll
            for (int m = 0; m < 4; ++m) {
                const size_t off = (size_t)(u.pm * 256 + ai * 128 + wr * 64 + m * 16 + fr) * DM + col0;
#pragma unroll
                for (int bj = 0; bj < 2; ++bj)
#pragma unroll
                    for (int n = 0; n < 2; ++n) { const f32x4 b = *(const f32x4*)(base + off + bj * 128 + n * 16); *(f32x4*)(out + off + bj * 128 + n * 16) = b * ALPHA + acc[ai][bj][m][n]; }
                asm volatile("" ::: "memory");
            }
    }
};
struct EpiGU {
    static constexpr bool PERM = false, AFTER_DRAIN = false;
    bf16_t* H; const float* gslot;
    __device__ __forceinline__ void operator()(const f32x4 (&acc)[2][2][4][2], const pg8::Unit& u, int wr, int wc, int fr, int fq) const {
        const int f0 = (u.pn & 3) * 128 + wc * 16 + 4 * fq;
#pragma unroll
        for (int ai = 0; ai < 2; ++ai)
#pragma unroll
            for (int m = 0; m < 4; ++m) {
                const int row = u.pm * 256 + ai * 128 + wr * 64 + m * 16 + fr;
                const float gw = gslot[row];
#pragma unroll
                for (int bj = 0; bj < 2; ++bj) {
                    const f32x4 g = acc[ai][bj][m][0], up = acc[ai][bj][m][1]; float h[4];
#pragma unroll
                    for (int i = 0; i < 4; ++i) h[i] = g[i] * sigmoidf_(g[i]) * up[i] * gw;
                    v2u w; w.x = pk2(h[0], h[1]); w.y = pk2(h[2], h[3]); *(v2u*)(H + (size_t)row * DE + f0 + bj * 64) = w;
                }
                asm volatile("" ::: "memory");
            }
    }
};
struct EpiDown {
    static constexpr bool PERM = false, AFTER_DRAIN = false;
    bf16_t* Y;
    __device__ __forceinline__ void operator()(const f32x4 (&acc)[2][2][4][2], const pg8::Unit& u, int wr, int wc, int fr, int fq) const {
        const int col0 = (u.pn & 3) * 256 + wc * 32 + 4 * fq;
#pragma unroll
        for (int ai = 0; ai < 2; ++ai)
#pragma unroll
            for (int m = 0; m < 4; ++m) {
                bf16_t* rowp = Y + (size_t)(u.pm * 256 + ai * 128 + wr * 64 + m * 16 + fr) * DM + col0;
#pragma unroll
                for (int bj = 0; bj < 2; ++bj)
#pragma unroll
                    for (int n = 0; n < 2; ++n) { const f32x4 v = acc[ai][bj][m][n]; v2u w; w.x = pk2(v[0], v[1]); w.y = pk2(v[2], v[3]); *(v2u*)(rowp + bj * 128 + n * 16) = w; }
            }
    }
};
struct GroupedOrder {
    const int* tab; int G, c, nunits;
    __device__ __forceinline__ void init(const int* tab_, int G_, int c_) { tab = tab_; G = G_; c = c_; nunits = ld_agent(tab_) * 4; }
    __device__ __forceinline__ bool next(int i, pg8::Unit& u) const {
        const int L = i * G + c; if (L >= nunits) return false;
        const int pm = L >> 2; const int e = ld_agent(tab + 1 + pm); u.pm = pm; u.pn = e * 4 + (L & 3); return true;
    }
    __device__ __forceinline__ void a_ready(const pg8::Unit&) const {}
    __device__ __forceinline__ void done(const pg8::Unit&) const {}
};

struct RowId { __device__ __forceinline__ int operator()(int n) const { return n; } };
struct RowGU { int up; __device__ __forceinline__ int operator()(int n) const { return 32 * (n >> 4) + (n & 15) + 16 * up; } };

template <class RM>
__device__ __forceinline__ void transpose_item(const float* W, int ldw, int krow0, int col0, int ncols, bf16_t* WT, int pitch, int koff, RM rm, LAS float* scr, int item, int lane) {
    const int nblk = (ncols + 31) >> 5, kb = item / nblk, nb = item - kb * nblk, k0 = 64 * kb, n0 = 32 * nb;
    const int nl = lane & 31; const bool nv = (n0 + nl) < ncols;
#pragma unroll 8
    for (int i = 0; i < 32; ++i) { const int kk = 2 * i + (lane >> 5); scr[kk * 33 + nl] = nv ? W[(size_t)(krow0 + k0 + kk) * ldw + col0 + n0 + nl] : 0.f; }
    LDS_WAIT();
    const int c = lane & 7;
#pragma unroll
    for (int j = 0; j < 4; ++j) { const int nn = (lane >> 3) + 8 * j; const LAS float* s = scr + (8 * c) * 33 + nn;
        if (n0 + nn < ncols) { v4u o; o.x = pk2(s[0 * 33], s[1 * 33]); o.y = pk2(s[2 * 33], s[3 * 33]); o.z = pk2(s[4 * 33], s[5 * 33]); o.w = pk2(s[6 * 33], s[7 * 33]);
            *(v4u*)(WT + (size_t)rm(n0 + nn) * pitch + koff + k0 + 8 * c) = o; } }
    LDS_WAIT();
}

__device__ __forceinline__ void absorb_q_task(const Frame& F, const float* w_in, const float* w_uk, const float* kvg, bf16_t* Win_t, int a) {
    const int h = a >> 6, kb = (a >> 2) & 15, rq = a & 3, k = kb * 64 + F.lane;
    f32x4 win[16];
    const f32x4* src = (const f32x4*)(w_in + (size_t)k * DIN + h * 64);
#pragma unroll
    for (int i = 0; i < 16; ++i) win[i] = src[i];
#pragma unroll 1
    for (int r = rq * 32; r < rq * 32 + 32; ++r) {
        const f32x4* wu = (const f32x4*)(w_uk + (size_t)(h * 128 + r) * 64);
        float acc = 0.f;
#pragma unroll
        for (int i = 0; i < 16; ++i) { const f32x4 u = wu[i]; acc += win[i][0] * u[0]; acc += win[i][1] * u[1]; acc += win[i][2] * u[2]; acc += win[i][3] * u[3]; }
        Win_t[(size_t)(h * 128 + r) * DM + k] = (bf16_t)f2bf(acc * 0.125f * kvg[r]);
    }
}
__device__ __forceinline__ void absorb_o_task(const Frame& F, const float* w_o, const float* w_uv, const float* kvg, bf16_t* Wo_t, int a) {
    const int h = a >> 6, nb = (a >> 2) & 15, rq = a & 3, n = nb * 64 + F.lane;
    float wo[64];
#pragma unroll
    for (int d = 0; d < 64; ++d) wo[d] = w_o[(size_t)(h * 64 + d) * DM + n];
#pragma unroll 1
    for (int r = rq * 32; r < rq * 32 + 32; ++r) {
        const f32x4* wu = (const f32x4*)(w_uv + (size_t)(h * 128 + r) * 64);
        float s = 0.f;
#pragma unroll
        for (int i = 0; i < 16; ++i) { const f32x4 u = wu[i]; s += wo[4 * i] * u[0]; s += wo[4 * i + 1] * u[1]; s += wo[4 * i + 2] * u[2]; s += wo[4 * i + 3] * u[3]; }
        Wo_t[(size_t)n * KMIX + h * 128 + r] = (bf16_t)f2bf(s * kvg[r]);
    }
}

__device__ __forceinline__ void phase_convert(const Frame& F0, int l, bool with_x) {
    const Frame F = relaunder(F0);
    KArgs A = kargs();
    const float* w_in = A->in[1] + (size_t)l * DM * DIN; const float* kvg = A->in[2] + l * 128;
    const float* w_uk = A->in[3] + (size_t)l * 8 * 128 * 64; const float* w_uv = A->in[4] + (size_t)l * 8 * 128 * 64;
    const float* w_o = A->in[11] + (size_t)l * DM * DM;
    const float* w_gate = A->in[16] + (size_t)l * NE * DM * DE; const float* w_up = A->in[17] + (size_t)l * NE * DM * DE; const float* w_down = A->in[18] + (size_t)l * NE * DE * DM;
    bf16_t* Win_t = ws_bf(A, WS_WIN); bf16_t* Wo_t = ws_bf(A, WS_WO); bf16_t* Wgu_t = ws_bf(A, WS_WGU); bf16_t* Wd_t = ws_bf(A, WS_WD);
    LAS float* scr = (LAS float*)(F.lds + F.wave * 16384);
    const int gw = F.bid * NWAVES + F.wave, NGW = F.G * NWAVES;
    constexpr int I_AQ = 512, I_AO = 512, I_IN = 16 * 38, I_O2 = 8 * 32, I_G1 = 256, I_D1 = 256, I_Z = 88;
    constexpr int NITEMS = I_AQ + I_AO + I_IN + I_O2 + NE * (2 * I_G1 + I_D1) + I_Z;
#pragma unroll 1
    for (int it = gw; it < NITEMS; it += NGW) {
        int r = it;
#ifndef NO_AQ
        if (r < I_AQ) { absorb_q_task(F, w_in, w_uk, kvg, Win_t, r); continue; }
#endif
        r -= I_AQ;
#ifndef NO_AO
        if (r < I_AO) { absorb_o_task(F, w_o, w_uv, kvg, Wo_t, r); continue; }
#endif
        r -= I_AO;
        if (r < I_IN) { transpose_item(w_in, DIN, 0, 512, DIN - 512, Win_t + (size_t)1024 * DM, DM, 0, RowId{}, scr, r, F.lane); continue; } r -= I_IN;
        if (r < I_O2) { transpose_item(w_o, DM, 512, 0, DM, Wo_t, KMIX, 1024, RowId{}, scr, r, F.lane); continue; } r -= I_O2;
        if (r < NE * 2 * I_G1) { const int e = r / (2 * I_G1), q = r % (2 * I_G1), up = q / I_G1, item = q % I_G1;
            transpose_item((up ? w_up : w_gate) + (size_t)e * DM * DE, DE, 0, 0, DE, Wgu_t + (size_t)e * 1024 * DM, DM, 0, RowGU{up}, scr, item, F.lane); continue; } r -= NE * 2 * I_G1;
        if (r < NE * I_D1) { const int e = r / I_D1, item = r % I_D1;
            transpose_item(w_down + (size_t)e * DE * DM, DM, 0, 0, DM, Wd_t + (size_t)e * 1024 * DE, DE, 0, RowId{}, scr, item, F.lane); continue; } r -= NE * I_D1;
        { v4u z = {0u, 0u, 0u, 0u}; v4u* p = (v4u*)(Win_t + (size_t)(C_END + r) * DM); p[F.lane] = z; p[F.lane + 64] = z; }
    }
    if (with_x) {
        const float* x = A->in[0]; bf16_t* xb = ws_bf(A, WS_XB);
#pragma unroll 1
        for (int m = gw; m < M; m += NGW) {
            const f32x4* xr = (const f32x4*)(x + (size_t)m * DM) + F.lane; v2u* o = (v2u*)(xb + (size_t)m * DM) + F.lane;
#pragma unroll
            for (int j = 0; j < 4; ++j) { const f32x4 v = xr[64 * j]; v2u w; w.x = pk2(v[0], v[1]); w.y = pk2(v[2], v[3]); o[64 * j] = w; }
        }
    }
}

struct MixP { const bf16_t* proj; bf16_t* ymix; const float *ssq, *conv_w, *conv_b, *cln_g, *cln_b, *w_pool, *pool_scale; };
__device__ __forceinline__ void conv_pool_tile(const Frame& F, const MixP& P, int tile) {
    const int tid = F.tid, lane = F.lane, wave = F.wave;
    const int row0 = tile * 32;
    const int tpos0 = row0 & (SEQ - 1);
    LAS float* hbuf = (LAS float*)F.lds;
#pragma unroll 1
    for (int task = tid; task < 62 * 32; task += NTHR) {
        const int j = task >> 5, c8 = (task & 31) * 8; const int tp = tpos0 - 30 + j;
        f32x4 h0 = {0.f, 0.f, 0.f, 0.f}, h1 = {0.f, 0.f, 0.f, 0.f};
        if (tp >= 0) {
            const bf16_t* p = P.proj + (size_t)(row0 - 30 + j) * NPROJ + C_UC + c8;
            const v4u a = *(const v4u*)p, g = *(const v4u*)(p + 256);
            h0[0] = bflo(a.x) * sigmoidf_(bflo(g.x)); h0[1] = bfhi(a.x) * sigmoidf_(bfhi(g.x)); h0[2] = bflo(a.y) * sigmoidf_(bflo(g.y)); h0[3] = bfhi(a.y) * sigmoidf_(bfhi(g.y));
            h1[0] = bflo(a.z) * sigmoidf_(bflo(g.z)); h1[1] = bfhi(a.z) * sigmoidf_(bfhi(g.z)); h1[2] = bflo(a.w) * sigmoidf_(bflo(g.w)); h1[3] = bfhi(a.w) * sigmoidf_(bfhi(g.w));
        }
        *(LAS f32x4*)(hbuf + j * 256 + c8) = h0; *(LAS f32x4*)(hbuf + j * 256 + c8 + 4) = h1;
    }
    __syncthreads();
    if (tid < 256) {
        const int c = tid; float w[31];
#pragma unroll
        for (int j = 0; j < 31; ++j) w[j] = P.conv_w[j * 256 + c];
        const float bias = P.conv_b[c];
#pragma unroll 1
        for (int t = 31; t >= 0; --t) {
            float acc = bias;
#pragma unroll
            for (int j = 0; j < 31; ++j) acc += hbuf[(t + j) * 256 + c] * w[j];
            hbuf[(t + 30) * 256 + c] = acc;
        }
    }
    __syncthreads();
#pragma unroll 1
    for (int i = wave; i < 32; i += NWAVES) {
        const f32x4 x = *(LAS f32x4*)(hbuf + (i + 30) * 256 + 4 * lane);
        const float mean = wave_sum((x[0] + x[1]) + (x[2] + x[3])) * (1.f / 256.f);
        const f32x4 d = x - mean;
        const float var = wave_sum((d[0] * d[0] + d[1] * d[1]) + (d[2] * d[2] + d[3] * d[3])) * (1.f / 256.f);
        const float rstd = 1.0f / sqrtf(var + LN_EPS);
        const f32x4 g = *(const f32x4*)(P.cln_g + 4 * lane), b = *(const f32x4*)(P.cln_b + 4 * lane);
        float y[4];
#pragma unroll
        for (int k = 0; k < 4; ++k) { const float z = d[k] * rstd * g[k] + b[k]; y[k] = z * sigmoidf_(z); }
        v2u w; w.x = pk2(y[0], y[1]); w.y = pk2(y[2], y[3]);
        *(v2u*)(P.ymix + (size_t)(row0 + i) * KMIX + 1280 + 4 * lane) = w;
    }
    __syncthreads();
    LAS float* pbuf = (LAS float*)F.lds; LAS float* plbuf = (LAS float*)(F.lds + 49152);
#pragma unroll 1
    for (int task = tid; task < 47 * 32; task += NTHR) {
        const int j = task >> 5, c8 = (task & 31) * 8; const int tp = tpos0 - 15 + j;
        f32x4 h0 = {0.f, 0.f, 0.f, 0.f}, h1 = {0.f, 0.f, 0.f, 0.f};
        if (tp >= 0) {
            const v4u a = *(const v4u*)(P.proj + (size_t)(row0 - 15 + j) * NPROJ + C_UP + c8);
            h0[0] = bflo(a.x); h0[1] = bfhi(a.x); h0[2] = bflo(a.y); h0[3] = bfhi(a.y); h1[0] = bflo(a.z); h1[1] = bfhi(a.z); h1[2] = bflo(a.w); h1[3] = bfhi(a.w);
        }
        *(LAS f32x4*)(pbuf + j * 256 + c8) = h0; *(LAS f32x4*)(pbuf + j * 256 + c8 + 4) = h1;
    }
    __syncthreads();
    {
        const int c = tid & 255, half = tid >> 8, gi = c >> 6, w = 2 << gi;
#pragma unroll 1
        for (int i = 0; i < 16; ++i) {
            const int t = half * 16 + i; float s = 0.f;
            for (int j = 0; j < w; ++j) s += pbuf[(t + 15 - j) * 256 + c];
            const int tp = tpos0 + t; const float cnt = (float)((tp + 1) < w ? (tp + 1) : w);
            plbuf[t * 256 + c] = s / cnt - pbuf[(t + 15) * 256 + c];
        }
    }
    __syncthreads();
    {
        const int dall = tid & 255, half = tid >> 8, g = dall >> 6, d = dall & 63;
        float acc[16];
#pragma unroll
        for (int i = 0; i < 16; ++i) acc[i] = 0.f;
        const float* wp = P.w_pool + (size_t)g * 64 * 64 + d;
#pragma unroll 2
        for (int c = 0; c < 64; ++c) {
            const float wv = wp[c * 64];
#pragma unroll
            for (int i = 0; i < 16; ++i) acc[i] += plbuf[(half * 16 + i) * 256 + g * 64 + c] * wv;
        }
        const float sc = P.pool_scale[dall];
#pragma unroll
        for (int i = 0; i < 16; ++i) P.ymix[(size_t)(row0 + half * 16 + i) * KMIX + 1024 + dall] = (bf16_t)f2bf(acc[i] * sc);
    }
    __syncthreads();
}

__device__ __forceinline__ unsigned f2ord(float f) { const unsigned u = __builtin_bit_cast(unsigned, f); return (u & 0x80000000u) ? ~u : (u | 0x80000000u); }

__device__ __forceinline__ void hist_scan(LAS unsigned* h, unsigned need, int lane, int& bin, unsigned& above) {
    const v4u c = *(LAS v4u*)(h + 4 * lane);
    const unsigned T = c.x + c.y + c.z + c.w;
    unsigned X = T;
#pragma unroll
    for (int o = 1; o < 64; o <<= 1) { const unsigned y = __shfl_down(X, o); if (lane + o < 64) X += y; }
    const unsigned long long mk = __ballot(X >= need);
    const int L = mk ? (63 - __clzll(mk)) : 0;
    const unsigned S3 = X - T + c.w, S2 = S3 + c.z, S1 = S2 + c.y;
    int bl; unsigned ab;
    if (S3 >= need) { bl = 3; ab = X - T; } else if (S2 >= need) { bl = 2; ab = S3; } else if (S1 >= need) { bl = 1; ab = S2; } else { bl = 0; ab = S1; }
    bin = __shfl(4 * lane + bl, L); above = (unsigned)__shfl((int)ab, L);
}

__device__ __forceinline__ int swz16(int row) { return ((row & 3) << 2) | ((row >> 2) & 3); }

__device__ __forceinline__ void dsa_group(const Frame& F, const MixP& P, int b, int t0) {
    const int lane = F.lane, w = F.wave, hh = lane >> 5, kl = lane & 31;
    LAS unsigned char* wl = F.lds + w * 16384;
    LAS unsigned short* sel = (LAS unsigned short*)wl;
    LAS unsigned* hist = (LAS unsigned*)(wl + 2048);
    LAS unsigned char* cbuf = wl + 6144;
    LAS float* rsbuf = (LAS float*)(wl + 14336);
    LAS bf16_t* obuf = (LAS bf16_t*)(wl + 2048);
    const bf16_t* projb = P.proj + (size_t)b * SEQ * NPROJ;
    const float* ssqb = P.ssq + (size_t)b * SEQ * 4;
    const int tq0 = t0 + 4 * w;

    if (t0 >= TOPK) {
        bf16x8 A0, A1;
        { const int r = kl, qa = 2 * ((r >> 2) & 1) + (r >> 4), head = (r & 3) + 4 * ((r >> 3) & 1);
          const bf16_t* ap = projb + (size_t)(tq0 + qa) * NPROJ + C_IQ + head * 32 + 8 * hh;
          A0 = *(const bf16x8*)ap; A1 = *(const bf16x8*)(ap + 16); }
        float wq[2][8];
#pragma unroll
        for (int j = 0; j < 2; ++j) { const v4u v = *(const v4u*)(projb + (size_t)(tq0 + 2 * hh + j) * NPROJ + C_IW);
            wq[j][0] = bflo(v.x); wq[j][1] = bfhi(v.x); wq[j][2] = bflo(v.y); wq[j][3] = bfhi(v.y); wq[j][4] = bflo(v.z); wq[j][5] = bfhi(v.z); wq[j][6] = bflo(v.w); wq[j][7] = bfhi(v.w); }
        const int tqj0 = tq0 + 2 * hh, tqj1 = tqj0 + 1;
        const int ntile = (t0 >> 5) + 1;
        { const v4u z = {0u, 0u, 0u, 0u};
#pragma unroll
          for (int i = 0; i < 4; ++i) *(LAS v4u*)(hist + 4 * (lane + 64 * i)) = z; }
        unsigned prefix0 = 0u, prefix1 = 0u, need0 = TOPK, need1 = TOPK;
        unsigned eqt0 = 0u, eqt1 = 0u, cnt0 = 0u, cnt1 = 0u;
        LDS_WAIT();
#pragma unroll 1
        for (int pass = 0; pass < 5; ++pass) {
            const int shift = 24 - 8 * pass;
            const unsigned himask = (pass == 0) ? 0u : (0xFFFFFFFFu << (32 - 8 * pass));
            const bf16_t* bp = projb + (size_t)kl * NPROJ + C_IK + 8 * hh;
            bf16x8 B0 = *(const bf16x8*)bp, B1 = *(const bf16x8*)(bp + 16);
#pragma unroll 1
            for (int kt = 0; kt < ntile; ++kt) {
                bf16x8 nB0 = B0, nB1 = B1;
                if (kt + 1 < ntile) { const bf16_t* np = bp + (size_t)(kt + 1) * 32 * NPROJ; nB0 = *(const bf16x8*)np; nB1 = *(const bf16x8*)(np + 16); }
                f32x16 acc = {0.f, 0.f, 0.f, 0.f, 0.f, 0.f, 0.f, 0.f, 0.f, 0.f, 0.f, 0.f, 0.f, 0.f, 0.f, 0.f};
                acc = __builtin_amdgcn_mfma_f32_32x32x16_bf16(A0, B0, acc, 0, 0, 0);
                acc = __builtin_amdgcn_mfma_f32_32x32x16_bf16(A1, B1, acc, 0, 0, 0);
                float s0 = 0.f, s1 = 0.f;
#pragma unroll
                for (int h = 0; h < 8; ++h) { s0 += wq[0][h] * fmaxf(acc[h], 0.f); s1 += wq[1][h] * fmaxf(acc[8 + h], 0.f); }
                s0 += 0.0f; s1 += 0.0f;
                const int kidx = kt * 32 + kl;
                const bool v0 = kidx <= tqj0, v1 = kidx <= tqj1;
                const unsigned u0 = f2ord(s0), u1 = f2ord(s1);
                if (pass < 4) {
                    if (v0 && ((u0 & himask) == prefix0)) __hip_atomic_fetch_add(hist + (2 * hh) * 256 + ((u0 >> shift) & 255u), 1u, __ATOMIC_RELAXED, __HIP_MEMORY_SCOPE_WORKGROUP);
                    if (v1 && ((u1 & himask) == prefix1)) __hip_atomic_fetch_add(hist + (2 * hh + 1) * 256 + ((u1 >> shift) & 255u), 1u, __ATOMIC_RELAXED, __HIP_MEMORY_SCOPE_WORKGROUP);
                } else {
                    const unsigned ltm = (1u << kl) - 1u;
                    {   const bool eq = v0 && (u0 == prefix0), gt = v0 && (u0 > prefix0);
                        const unsigned long long me = __ballot(eq); const unsigned m32 = hh ? (unsigned)(me >> 32) : (unsigned)me;
                        const bool take = gt || (eq && (eqt0 + __popc(m32 & ltm) < need0)); eqt0 += __popc(m32);
                        const unsigned long long mt = __ballot(take); const unsigned t32 = hh ? (unsigned)(mt >> 32) : (unsigned)mt;
                        const unsigned pos = cnt0 + __popc(t32 & ltm); if (take && pos < TOPK) sel[(2 * hh) * 256 + pos] = (unsigned short)kidx; cnt0 += __popc(t32); }
                    {   const bool eq = v1 && (u1 == prefix1), gt = v1 && (u1 > prefix1);
                        const unsigned long long me = __ballot(eq); const unsigned m32 = hh ? (unsigned)(me >> 32) : (unsigned)me;
                        const bool take = gt || (eq && (eqt1 + __popc(m32 & ltm) < need1)); eqt1 += __popc(m32);
                        const unsigned long long mt = __ballot(take); const unsigned t32 = hh ? (unsigned)(mt >> 32) : (unsigned)mt;
                        const unsigned pos = cnt1 + __popc(t32 & ltm); if (take && pos < TOPK) sel[(2 * hh + 1) * 256 + pos] = (unsigned short)kidx; cnt1 += __popc(t32); }
                }
                B0 = nB0; B1 = nB1;
            }
            LDS_WAIT();
            if (pass < 4) {
#pragma unroll
                for (int qq = 0; qq < 4; ++qq) {
                    const unsigned nd = (unsigned)__shfl((int)((qq & 1) ? need1 : need0), (qq >> 1) * 32);
                    int bin; unsigned above;
                    hist_scan(hist + qq * 256, nd, lane, bin, above);
                    if (hh == (qq >> 1)) { if (qq & 1) { prefix1 |= (unsigned)bin << shift; need1 -= above; } else { prefix0 |= (unsigned)bin << shift; need0 -= above; } }
                    const v4u z = {0u, 0u, 0u, 0u}; *(LAS v4u*)(hist + qq * 256 + 4 * lane) = z;
                }
                LDS_WAIT();
            }
        }
    } else {
#pragma unroll
        for (int qq = 0; qq < 4; ++qq)
#pragma unroll
            for (int i = 0; i < 4; ++i) sel[qq * 256 + lane + 64 * i] = (unsigned short)(lane + 64 * i);
        LDS_WAIT();
    }

    const int n16 = lane & 15, g = lane >> 4;
#pragma unroll 1
    for (int qq = 0; qq < 4; ++qq) {
        const int tq = tq0 + qq; const int nsel = (tq + 1) < TOPK ? (tq + 1) : TOPK;
        bf16x8 Bq[4];
#pragma unroll
        for (int ks = 0; ks < 4; ++ks) {
            bf16x8 z = {0, 0, 0, 0, 0, 0, 0, 0};
            if (n16 < 8) z = *(const bf16x8*)(projb + (size_t)tq * NPROJ + C_QL + n16 * 128 + 32 * ks + 8 * g);
            Bq[ks] = z;
        }
        float m_run = -INFINITY, lsum = 0.f;
        f32x4 O[8];
#pragma unroll
        for (int ct = 0; ct < 8; ++ct) O[ct] = (f32x4){0.f, 0.f, 0.f, 0.f};
        const int nch = (nsel + 31) >> 5;
#pragma unroll 1
        for (int c = 0; c < nch; ++c) {
            v4u gv[8];
#pragma unroll
            for (int it = 0; it < 8; ++it) {
                const int i = g + 4 * it; const int si = 32 * c + i;
                const int ki = (si < nsel) ? (int)sel[qq * 256 + si] : 0;
                gv[it] = *(const v4u*)(projb + (size_t)ki * NPROJ + C_CKV + n16 * 8);
            }
            if (lane < 32) {
                const int si = 32 * c + lane; const int ki = (si < nsel) ? (int)sel[qq * 256 + si] : 0;
                const f32x4 p = *(const f32x4*)(ssqb + (size_t)ki * 4);
                rsbuf[lane] = 1.0f / sqrtf(((p[0] + p[1]) + (p[2] + p[3])) * (1.f / 128.f) + LN_EPS);
            }
#pragma unroll
            for (int it = 0; it < 8; ++it) { const int i = g + 4 * it; *(LAS v4u*)(cbuf + 256 * i + 16 * (n16 ^ swz16(i))) = gv[it]; }
            LDS_WAIT();
            f32x4 sc[2];
#pragma unroll
            for (int tt = 0; tt < 2; ++tt) {
                f32x4 a = {0.f, 0.f, 0.f, 0.f};
                const int row = 16 * tt + n16;
#pragma unroll
                for (int ks = 0; ks < 4; ++ks) {
                    const bf16x8 af = *(LAS bf16x8*)(cbuf + 256 * row + 16 * ((4 * ks + g) ^ swz16(row)));
                    a = __builtin_amdgcn_mfma_f32_16x16x32_bf16(af, Bq[ks], a, 0, 0, 0);
                }
                sc[tt] = a;
            }
            f32x4 rsv[2];
            rsv[0] = *(LAS f32x4*)(rsbuf + 4 * g); rsv[1] = *(LAS f32x4*)(rsbuf + 16 + 4 * g);
            float cmax = -INFINITY;
#pragma unroll
            for (int tt = 0; tt < 2; ++tt)
#pragma unroll
                for (int r = 0; r < 4; ++r) { float s = sc[tt][r] * rsv[tt][r]; if (32 * c + 16 * tt + 4 * g + r >= nsel) s = -INFINITY; sc[tt][r] = s; cmax = fmaxf(cmax, s); }
            cmax = fmaxf(cmax, __shfl_xor(cmax, 16)); cmax = fmaxf(cmax, __shfl_xor(cmax, 32));
            const float mnew = fmaxf(m_run, cmax);
            const float alpha = __expf(m_run - mnew);
            float psum = 0.f; float pp[2][4];
#pragma unroll
            for (int tt = 0; tt < 2; ++tt)
#pragma unroll
                for (int r = 0; r < 4; ++r) { const float p = __expf(sc[tt][r] - mnew); psum += p; pp[tt][r] = p * rsv[tt][r]; }
            lsum = lsum * alpha + psum; m_run = mnew;
            bf16x8 PA;
            { v4u pw; pw.x = pk2(pp[0][0], pp[0][1]); pw.y = pk2(pp[0][2], pp[0][3]); pw.z = pk2(pp[1][0], pp[1][1]); pw.w = pk2(pp[1][2], pp[1][3]); PA = __builtin_bit_cast(bf16x8, pw); }
            float ar[4];
#pragma unroll
            for (int r = 0; r < 4; ++r) ar[r] = __shfl(alpha, 4 * g + r);
#pragma unroll
            for (int ct = 0; ct < 8; ++ct) { O[ct][0] *= ar[0]; O[ct][1] *= ar[1]; O[ct][2] *= ar[2]; O[ct][3] *= ar[3]; }
            { const int qrow = (n16 >> 2), p4 = n16 & 3;
              const int rlo = 4 * g + qrow, rhi = 16 + 4 * g + qrow;
#pragma unroll
              for (int ct = 0; ct < 8; ++ct) {
                  const int ch = 2 * ct + (p4 >> 1);
                  const s16x4 lo = __builtin_bit_cast(s16x4, __builtin_amdgcn_ds_read_tr16_b64_v4i16((LAS s16x4*)(cbuf + 256 * rlo + 16 * (ch ^ swz16(rlo)) + 8 * (p4 & 1))));
                  const s16x4 hi = __builtin_bit_cast(s16x4, __builtin_amdgcn_ds_read_tr16_b64_v4i16((LAS s16x4*)(cbuf + 256 * rhi + 16 * (ch ^ swz16(rhi)) + 8 * (p4 & 1))));
                  const bf16x8 vf = {lo[0], lo[1], lo[2], lo[3], hi[0], hi[1], hi[2], hi[3]};
                  O[ct] = __builtin_amdgcn_mfma_f32_16x16x32_bf16(PA, vf, O[ct], 0, 0, 0);
              } }
            LDS_WAIT();
            asm volatile("" ::: "memory");
        }
        float ltot = lsum; ltot += __shfl_xor(ltot, 16); ltot += __shfl_xor(ltot, 32);
        const float inv = 1.0f / ltot;
        float ir[4];
#pragma unroll
        for (int r = 0; r < 4; ++r) ir[r] = __shfl(inv, 4 * g + r);
        if (g < 2) {
#pragma unroll
            for (int ct = 0; ct < 8; ++ct)
#pragma unroll
                for (int r = 0; r < 4; ++r) obuf[(4 * g + r) * 128 + 16 * ct + n16] = (bf16_t)f2bf(O[ct][r] * ir[r]);
        }
        LDS_WAIT();
        { bf16_t* dst = P.ymix + (size_t)(b * SEQ + tq) * KMIX;
#pragma unroll
          for (int k = 0; k < 2; ++k) { const int piece = lane + 64 * k; *(v4u*)(dst + piece * 8) = *(LAS v4u*)((LAS unsigned char*)obuf + piece * 16); } }
        LDS_WAIT();
        asm volatile("" ::: "memory");
    }
}

__device__ __forceinline__ void phase_mixers(const Frame& F0, int l) {
    const Frame F = relaunder(F0);
    KArgs A = kargs();
    MixP P;
    P.proj = ws_bf(A, WS_PROJ); P.ymix = ws_bf(A, WS_YMIX); P.ssq = (const float*)(A->ws + WS_SSQ);
    P.w_pool = A->in[5] + (size_t)l * 4 * 64 * 64; P.pool_scale = A->in[6] + l * 256; P.conv_w = A->in[7] + (size_t)l * 31 * 256; P.conv_b = A->in[8] + l * 256;
    P.cln_g = A->in[9] + l * 256; P.cln_b = A->in[10] + l * 256;
#ifndef NO_CONVPOOL
#pragma unroll 1
    for (int tile = F.bid; tile < M / 32; tile += F.G) conv_pool_tile(F, P, tile);
#endif
    __syncthreads();
#pragma unroll 1
    for (int it = F.bid; it < 512; it += F.G) {
        const int b = it >> 8, gi = it & 255; const int grp = b ? (255 - gi) : gi;
#ifndef NO_DSA
        dsa_group(F, P, b, grp * 32);
#endif
    }
    __syncthreads();
}

__device__ __forceinline__ float top2sum4(float a, float b, float c, float d) {
    const float hi1 = fmaxf(a, b), lo1 = fminf(a, b), hi2 = fmaxf(c, d), lo2 = fminf(c, d);
    const float top = fmaxf(hi1, hi2), second = fmaxf(fminf(hi1, hi2), (hi1 >= hi2) ? lo1 : lo2);
    return top + second;
}
__device__ __forceinline__ void phase_ln1_router(const Frame& F0, int l) {
    const Frame F = relaunder(F0);
    KArgs A = kargs();
    float* out = A->out; bf16_t* xb = ws_bf(A, WS_XB);
    const float* ln1_g = A->in[12] + l * DM; const float* ln1_b = A->in[13] + l * DM; const float* router_w = A->in[14]; const float* router_b = A->in[15];
    int* toke = (int*)(A->ws + WS_TOKE); float* tokg = (float*)(A->ws + WS_TOKG); unsigned* blkcnt = (unsigned*)(A->ws + WS_BLKCNT);
    const int lane = F.lane, wave = F.wave;
    LAS float* xs = (LAS float*)(F.lds + wave * 4096);
    LAS unsigned* cnt = (LAS unsigned*)(F.lds + LDS_MISC + 512);
    if (F.tid < 16) cnt[F.tid] = 0u;
    __syncthreads();
    const int e16 = lane & 15, qr = lane >> 4;
    const float bias_e = router_b[e16];
#pragma unroll 1
    for (int i = 0; i < 8; ++i) {
        const int row = F.bid * 64 + wave * 8 + i;
        float* vr = out + (size_t)row * DM;
        f32x4 v[4]; float s = 0.f;
#pragma unroll
        for (int j = 0; j < 4; ++j) { v[j] = *(const f32x4*)(vr + 4 * lane + 256 * j); s += (v[j][0] + v[j][1]) + (v[j][2] + v[j][3]); }
        const float mean = wave_sum(s) * (1.f / DM); float s2 = 0.f;
#pragma unroll
        for (int j = 0; j < 4; ++j) { v[j] = v[j] - mean; s2 += (v[j][0] * v[j][0] + v[j][1] * v[j][1]) + (v[j][2] * v[j][2] + v[j][3] * v[j][3]); }
        const float rstd = 1.0f / sqrtf(wave_sum(s2) * (1.f / DM) + LN_EPS);
#pragma unroll
        for (int j = 0; j < 4; ++j) {
            const f32x4 g = *(const f32x4*)(ln1_g + 4 * lane + 256 * j), b = *(const f32x4*)(ln1_b + 4 * lane + 256 * j);
            const f32x4 y = v[j] * rstd * g + b;
            *(f32x4*)(vr + 4 * lane + 256 * j) = y;
            v2u w; w.x = pk2(y[0], y[1]); w.y = pk2(y[2], y[3]); *(v2u*)(xb + (size_t)row * DM + 4 * lane + 256 * j) = w;
            *(LAS f32x4*)(xs + 4 * lane + 256 * j) = y;
        }
        LDS_WAIT();
        float acc = 0.f;
        { const float* rw = router_w + (size_t)(qr * 256) * NE + e16; const LAS float* xq = xs + qr * 256;
#pragma unroll 8
          for (int c = 0; c < 256; ++c) acc += xq[c] * rw[c * NE]; }
        acc += __shfl_xor(acc, 16); acc += __shfl_xor(acc, 32);
        const float aff = sigmoidf_(acc), scv = aff + bias_e;
        float sv[16];
#pragma unroll
        for (int k = 0; k < 16; ++k) sv[k] = __shfl(scv, k);
        float gs[4];
#pragma unroll
        for (int gq = 0; gq < 4; ++gq) gs[gq] = top2sum4(sv[4 * gq], sv[4 * gq + 1], sv[4 * gq + 2], sv[4 * gq + 3]);
        int best = 0; float bv = gs[0];
#pragma unroll
        for (int gq = 1; gq < 4; ++gq) if (gs[gq] > bv) { bv = gs[gq]; best = gq; }
        float c0 = sv[0], c1 = sv[1], c2 = sv[2], c3 = sv[3];
#pragma unroll
        for (int gq = 1; gq < 4; ++gq) if (best == gq) { c0 = sv[4 * gq]; c1 = sv[4 * gq + 1]; c2 = sv[4 * gq + 2]; c3 = sv[4 * gq + 3]; }
        int i1 = 0; float m1 = c0;
        if (c1 > m1) { m1 = c1; i1 = 1; } if (c2 > m1) { m1 = c2; i1 = 2; } if (c3 > m1) { m1 = c3; i1 = 3; }
        int i2 = -1; float m2 = -INFINITY;
        if (i1 != 0 && c0 > m2) { m2 = c0; i2 = 0; } if (i1 != 1 && c1 > m2) { m2 = c1; i2 = 1; } if (i1 != 2 && c2 > m2) { m2 = c2; i2 = 2; } if (i1 != 3 && c3 > m2) { m2 = c3; i2 = 3; }
        if (i2 < 0) i2 = (i1 == 0) ? 1 : 0;
        const int e1 = 4 * best + i1, e2 = 4 * best + i2;
        const float a1 = __shfl(aff, e1), a2 = __shfl(aff, e2);
        const float den = a1 + a2;
        if (lane == 0) {
            toke[row * 2] = e1; toke[row * 2 + 1] = e2; tokg[row * 2] = a1 / den; tokg[row * 2 + 1] = a2 / den;
            __hip_atomic_fetch_add(cnt + e1, 1u, __ATOMIC_RELAXED, __HIP_MEMORY_SCOPE_WORKGROUP);
            __hip_atomic_fetch_add(cnt + e2, 1u, __ATOMIC_RELAXED, __HIP_MEMORY_SCOPE_WORKGROUP);
        }
        LDS_WAIT();
    }
    __syncthreads();
    if (F.tid < 16) blkcnt[F.bid * 16 + F.tid] = cnt[F.tid];
}

__device__ __forceinline__ void phase_route(const Frame& F0) {
    const Frame F = relaunder(F0);
    KArgs A = kargs();
    const bf16_t* xb = ws_bf(A, WS_XB); bf16_t* xs = ws_bf(A, WS_XS);
    const int* toke = (const int*)(A->ws + WS_TOKE); const float* tokg = (const float*)(A->ws + WS_TOKG); int* toks = (int*)(A->ws + WS_TOKS);
    float* gslot = (float*)(A->ws + WS_GSLOT); int* tiletab = (int*)(A->ws + WS_TILETAB); const unsigned* blkcnt = (const unsigned*)(A->ws + WS_BLKCNT);
    const int lane = F.lane, wave = F.wave;
    LAS int* slots = (LAS int*)(F.lds + LDS_MISC + 1024);
    if (wave == 0) {
        const int e = lane & 15, part = lane >> 4;
        unsigned tot = 0u, pre = 0u;
        for (int bb = part; bb < F.G; bb += 4) { const unsigned c = (unsigned)ld_agent((const int*)blkcnt + bb * 16 + e); tot += c; if (bb < F.bid) pre += c; }
        tot += __shfl_xor((int)tot, 16); tot += __shfl_xor((int)tot, 32);
        pre += __shfl_xor((int)pre, 16); pre += __shfl_xor((int)pre, 32);
        const unsigned padded = (tot + 255u) & ~255u;
        unsigned off = 0u, total_pad = 0u;
#pragma unroll
        for (int k = 0; k < 16; ++k) { const unsigned pk = (unsigned)__shfl((int)padded, k); if (k < e) off += pk; total_pad += pk; }
        unsigned base = off + pre;
#pragma unroll 1
        for (int i = 0; i < 64; ++i) {
            const int row = F.bid * 64 + i;
            const int e1 = ld_agent(toke + row * 2), e2 = ld_agent(toke + row * 2 + 1);
            const unsigned s1 = (unsigned)__shfl((int)base, e1); base += (e == e1) ? 1u : 0u;
            const unsigned s2 = (unsigned)__shfl((int)base, e2); base += (e == e2) ? 1u : 0u;
            if (lane == 0) {
                slots[2 * i] = (int)s1; slots[2 * i + 1] = (int)s2; toks[row * 2] = (int)s1; toks[row * 2 + 1] = (int)s2;
                gslot[s1] = ld_agent_f(tokg + row * 2); gslot[s2] = ld_agent_f(tokg + row * 2 + 1);
            }
        }
        if (F.bid == 0) {
            const int ntile = (int)(total_pad >> 8);
            if (lane == 0) tiletab[0] = ntile;
            for (int t = lane; t < ntile; t += 64) {
                int ex = 0;
#pragma unroll
                for (int k = 0; k < 16; ++k) { const unsigned ok = (unsigned)__shfl((int)off, k); if ((unsigned)(t * 256) >= ok) ex = k; }
                tiletab[1 + t] = ex;
            }
#pragma unroll
            for (int k = 0; k < 16; ++k) {
                const unsigned ok = (unsigned)__shfl((int)off, k), tk = (unsigned)__shfl((int)tot, k), pk = (unsigned)__shfl((int)padded, k);
                for (unsigned s = ok + tk + lane; s < ok + pk; s += 64) gslot[s] = 0.f;
            }
        }
    }
    LDS_WAIT();
    __syncthreads();
#pragma unroll 1
    for (int i = 0; i < 8; ++i) {
        const int ti = wave * 8 + i, row = F.bid * 64 + ti;
        const v4u a = *(const v4u*)(xb + (size_t)row * DM + lane * 8), b = *(const v4u*)(xb + (size_t)row * DM + 512 + lane * 8);
#pragma unroll
        for (int k = 0; k < 2; ++k) { const int s = slots[2 * ti + k]; bf16_t* d = xs + (size_t)s * DM; *(v4u*)(d + lane * 8) = a; *(v4u*)(d + 512 + lane * 8) = b; }
    }
}

__device__ __forceinline__ void phase_ln2(const Frame& F0, int l) {
    const Frame F = relaunder(F0);
    KArgs A = kargs();
    float* out = A->out; bf16_t* xb = ws_bf(A, WS_XB); const int* toks = (const int*)(A->ws + WS_TOKS);
    const float* ln2_g = A->in[19] + l * DM; const float* ln2_b = A->in[20] + l * DM;
    const int lane = F.lane, wave = F.wave;
    const bf16_t* Y = ws_bf(A, WS_XS);
#pragma unroll 1
    for (int i = 0; i < 8; ++i) {
        const int row = F.bid * 64 + wave * 8 + i;
        const int s0 = ld_agent(toks + row * 2), s1 = ld_agent(toks + row * 2 + 1);
        float* vr = out + (size_t)row * DM;
        f32x4 v[4]; float s = 0.f;
#pragma unroll
        for (int j = 0; j < 4; ++j) {
            const f32x4 x = *(const f32x4*)(vr + 4 * lane + 256 * j);
            const v2u y0 = *(const v2u*)(Y + (size_t)s0 * DM + 4 * lane + 256 * j), y1 = *(const v2u*)(Y + (size_t)s1 * DM + 4 * lane + 256 * j);
            f32x4 f; f[0] = bflo(y0.x) + bflo(y1.x); f[1] = bfhi(y0.x) + bfhi(y1.x); f[2] = bflo(y0.y) + bflo(y1.y); f[3] = bfhi(y0.y) + bfhi(y1.y);
            v[j] = x * ALPHA + f; s += (v[j][0] + v[j][1]) + (v[j][2] + v[j][3]);
        }
        const float mean = wave_sum(s) * (1.f / DM); float s2 = 0.f;
#pragma unroll
        for (int j = 0; j < 4; ++j) { v[j] = v[j] - mean; s2 += (v[j][0] * v[j][0] + v[j][1] * v[j][1]) + (v[j][2] * v[j][2] + v[j][3] * v[j][3]); }
        const float rstd = 1.0f / sqrtf(wave_sum(s2) * (1.f / DM) + LN_EPS);
#pragma unroll
        for (int j = 0; j < 4; ++j) {
            const f32x4 g = *(const f32x4*)(ln2_g + 4 * lane + 256 * j), b = *(const f32x4*)(ln2_b + 4 * lane + 256 * j);
            const f32x4 y = v[j] * rstd * g + b;
            *(f32x4*)(vr + 4 * lane + 256 * j) = y;
            v2u w; w.x = pk2(y[0], y[1]); w.y = pk2(y[2], y[3]); *(v2u*)(xb + (size_t)row * DM + 4 * lane + 256 * j) = w;
        }
    }
}

constexpr int N_PHASES = 17;

__global__ void __launch_bounds__(NTHR, 2) fwd_kernel(Args args) {
    extern __shared__ __attribute__((aligned(16))) unsigned char lds_raw[];
    cg::grid_group grid = cg::this_grid();
    Frame F;
    F.lds = (LAS unsigned char*)lds_raw;
    F.tid = threadIdx.x; F.lane = F.tid & 63; F.wave = __builtin_amdgcn_readfirstlane(F.tid >> 6);
    F.G = gridDim.x; F.bid = blockIdx.x;
    const int lo = args.ph_lo, hi = args.ph_hi, coop = args.coop;
#ifndef PHMASK
#define PHMASK 0x1ff
#endif
#define IN(k) (lo <= (k) && (k) < hi)
#define EN(b) ((PHMASK >> (b)) & 1)
#define SEAM(k) do { if (IN(k) && IN((k) + 1)) { if (coop) grid.sync(); } } while (0)

    if (EN(0) && IN(0)) phase_convert(F, 0, true);
    SEAM(0);
#pragma unroll 1
    for (int l = 0; l < 2; ++l) {
        const int pb = 1 + 8 * l;
        if (EN(1) && IN(pb + 0)) {
            KArgs A = kargs();
            pg8::Gemm g{ws_bf(A, WS_XB), ws_bf(A, WS_WIN), M, NPROJ, DM}; pg8::StaticOrder S; S.init(M, NPROJ, F.G, F.bid);
            EpiProj E{ws_bf(A, WS_PROJ), (float*)(A->ws + WS_SSQ)};
            pg8::gemm_phase<EpiProj, pg8::StaticOrder, true, true>(F.lds, g, S, E);
        }
        SEAM(pb + 0);
        if (EN(2) && IN(pb + 1)) phase_mixers(F, l);
        SEAM(pb + 1);
        if (EN(3) && IN(pb + 2)) {
            KArgs A = kargs();
            pg8::Gemm g{ws_bf(A, WS_YMIX), ws_bf(A, WS_WO), M, DM, KMIX}; pg8::StaticOrder S; S.init(M, DM, F.G, F.bid);
            EpiMix E{l == 0 ? A->in[0] : (const float*)A->out, A->out};
            pg8::gemm_phase<EpiMix, pg8::StaticOrder, true, true>(F.lds, g, S, E);
        }
        SEAM(pb + 2);
        if (EN(4) && IN(pb + 3)) phase_ln1_router(F, l);
        SEAM(pb + 3);
        if (EN(5) && IN(pb + 4)) phase_route(F);
        SEAM(pb + 4);
        if (EN(6) && IN(pb + 5)) {
            KArgs A = kargs();
            pg8::Gemm g{ws_bf(A, WS_XS), ws_bf(A, WS_WGU), MAXSLOT, NE * 1024, DM}; GroupedOrder S; S.init((const int*)(A->ws + WS_TILETAB), F.G, F.bid);
            EpiGU E{ws_bf(A, WS_H), (const float*)(A->ws + WS_GSLOT)};
            pg8::gemm_phase<EpiGU, GroupedOrder, true, true>(F.lds, g, S, E);
        }
        SEAM(pb + 5);
        if (EN(7) && IN(pb + 6)) {
            KArgs A = kargs();
            pg8::Gemm g{ws_bf(A, WS_H), ws_bf(A, WS_WD), MAXSLOT, NE * 1024, DE}; GroupedOrder S; S.init((const int*)(A->ws + WS_TILETAB), F.G, F.bid);
            EpiDown E{ws_bf(A, WS_XS)};
            pg8::gemm_phase<EpiDown, GroupedOrder, true, true>(F.lds, g, S, E);
        }
        SEAM(pb + 6);
        if (EN(8) && IN(pb + 7)) {
            phase_ln2(F, l);
            if (l == 0) { __syncthreads(); phase_convert(F, 1, false); }
        }
        if (l == 0) SEAM(pb + 7);
    }
#undef IN
#undef SEAM
}

#ifndef MK_N_LAUNCHES
#define MK_N_LAUNCHES 1
#endif

extern "C" void kernel_launch(void* const* d_in, const int* in_sizes, int n_in, void* d_out, int out_size, void* d_ws, size_t ws_size, hipStream_t stream) {
    static int grid = 0;
    if (grid == 0) {
        int dev = 0, cus = 0, per_cu = 0;
        if (n_in != 21 || out_size != M * DM || ws_size < WS_END) { fprintf(stderr, "kernel_launch: unexpected problem (n_in %d out %d ws %zu)\n", n_in, out_size, ws_size); grid = -1; return; }
        if (hipGetDevice(&dev) != hipSuccess || hipDeviceGetAttribute(&cus, hipDeviceAttributeMultiprocessorCount, dev) != hipSuccess) { grid = -1; return; }
        if (hipFuncSetAttribute((const void*)fwd_kernel, hipFuncAttributeMaxDynamicSharedMemorySize, LDS_BYTES) != hipSuccess) { fprintf(stderr, "kernel_launch: hipFuncSetAttribute failed\n"); grid = -1; return; }
        if (hipOccupancyMaxActiveBlocksPerMultiprocessor(&per_cu, (const void*)fwd_kernel, NTHR, LDS_BYTES) != hipSuccess || per_cu < 1) { fprintf(stderr, "kernel_launch: occupancy query says %d\n", per_cu); grid = -1; (void)hipGetLastError(); return; }
        grid = cus;
        if (grid != 256) { fprintf(stderr, "kernel_launch: built for 256 CUs, found %d\n", cus); grid = -1; return; }
    }
    if (grid < 0) return;
    Args a{};
    for (int i = 0; i < 21; ++i) a.in[i] = (const float*)d_in[i];
    a.out = (float*)d_out; a.ws = (unsigned char*)d_ws; a.pad = 0;
#if MK_N_LAUNCHES == 1
    a.ph_lo = 0; a.ph_hi = N_PHASES; a.coop = 1;
    void* kargs[] = {&a};
    hipError_t e = hipLaunchCooperativeKernel((const void*)fwd_kernel, dim3(grid), dim3(NTHR), kargs, LDS_BYTES, stream);
    if (e != hipSuccess) fprintf(stderr, "kernel_launch: cooperative launch failed: %s\n", hipGetErrorString(e));
#else
    for (int p = 0; p < N_PHASES; ++p) {
        a.ph_lo = p; a.ph_hi = p + 1; a.coop = 0;
        hipLaunchKernelGGL(fwd_kernel, dim3(grid), dim3(NTHR), LDS_BYTES, stream, a);
    }
#endif
}
```

```cpp
#include <hip/hip_runtime.h>
#include <hip/hip_cooperative_groups.h>
#include <cstdio>
#include <cstdint>
namespace cg = cooperative_groups;
namespace pg8 {
#define PG8_LAS __attribute__((address_space(3)))
typedef unsigned short bf16_t;
typedef short bf16x8 __attribute__((ext_vector_type(8)));
typedef float f32x4 __attribute__((ext_vector_type(4)));
typedef unsigned u32x4 __attribute__((ext_vector_type(4)));
constexpr int BM = 256, BK = 64, HALF = 128, HTB = HALF * BK * 2  , STAGE_BYTES = 8 * HTB, NXCD = 8, WGM = 8;

__host__ __device__ __forceinline__ int lds_byte(int r, int c) { const int st = (r >> 4) * 2 + (c >> 5), rr = r & 15, cc = c & 31, ob = rr * 64 + cc * 2; return st * 1024 + (ob ^ (((ob >> 9) & 1) << 5)); }
__host__ __device__ __forceinline__ void stage_rc(int b, int& R, int& C) { const int st = b / 1024, sb = b % 1024, swz = sb ^ (((sb >> 9) & 1) << 5); R = (st >> 1) * 16 + swz / 64; C = (st & 1) * 32 + (swz % 64) / 2; }
__host__ __device__ __forceinline__ int perm32(int rho) { const int n = rho >> 4, i = rho & 15; return 8 * (i >> 2) + 4 * n + (i & 3); }

struct Unit { int pm, pn; };
struct Gemm { const bf16_t* A; const bf16_t* Bt; int M, N, K; };

struct StaticOrder {
    int nM, nN, nwg, G, c;
    __host__ __device__ void init(int M, int N, int G_, int c_) { nM = M / BM; nN = N / BM; nwg = nM * nN; G = G_; c = c_; }
    __host__ __device__ bool next(int i, Unit& u) const {
        const long L = (long)i * G + c; if (L >= nwg) return false;
        int wgid = (int)L; { const int q = nwg / NXCD, r = nwg % NXCD, xcd = wgid % NXCD, off = wgid / NXCD; wgid = (xcd < r ? xcd * (q + 1) : r * (q + 1) + (xcd - r) * q) + off; }
        const int nig = WGM * nN, gid = wgid / nig, fm = gid * WGM, gsz = (nM - fm) < WGM ? (nM - fm) : WGM;
        u.pm = fm + ((wgid % nig) % gsz); u.pn = (wgid % nig) / gsz; return true;
    }
    __device__ __forceinline__ void a_ready(const Unit&) const {}
    __device__ __forceinline__ void done(const Unit&) const {}
};

template <class Epi, class Sched, bool ALIGN_EPI = false, bool SP2 = false>
__device__ __forceinline__ void gemm_phase(PG8_LAS unsigned char* lds, const Gemm g, const Sched& S, const Epi& E) {
    int tid_ = threadIdx.x; asm volatile("" : "+v"(tid_));
    const int tid = tid_, wid = __builtin_amdgcn_readfirstlane(tid >> 6), lane = tid & 63, wr = wid >> 2, wc = wid & 3, fr = lane & 15, fq = lane >> 4;
    const int K = g.K, nt = K / BK;
    unsigned voffA[2], voffB[2];
#pragma unroll
    for (int i = 0; i < 2; ++i) { int R, C; stage_rc(tid * 16 + i * 8192, R, C); const int Rb = Epi::PERM ? ((R & ~31) + perm32(R & 31)) : R;
        voffA[i] = (unsigned)(R * K + C) * 2u; voffB[i] = (unsigned)(Rb * K + C) * 2u; }
    const size_t kstep = (size_t)(BK * 2);
    const size_t hstep = (size_t)HALF * K * 2;
    const size_t tstep = 2 * hstep;
    const unsigned ldsw = (unsigned)wid * 1024u;
    const int aoff = lds_byte(wr * 64 + fr, fq * 8), boff = lds_byte(wc * 32 + fr, fq * 8);
#define PG8_SA(b, h) (((b) * 2 + (h)) * HTB)
#define PG8_SB(b, h) ((4 + (b) * 2 + (h)) * HTB)
#define PG8_STAGE(bufoff, gbase, voff) do { _Pragma("unroll") for (int _i = 0; _i < 2; ++_i) \
        __builtin_amdgcn_global_load_lds((const unsigned*)((const char*)(gbase) + (voff)[_i]), (PG8_LAS unsigned*)(lds + (bufoff) + ldsw + _i * 8192), 16, 0, 0); } while (0)
#define PG8_LDA(dst, b, h) do { _Pragma("unroll") for (int m = 0; m < 4; ++m) _Pragma("unroll") for (int k = 0; k < 2; ++k) dst[m][k] = *(const PG8_LAS bf16x8*)(lds + PG8_SA(b, h) + aoff + m * 2048 + k * 1024); } while (0)
#define PG8_LDB(dst, b, h) do { _Pragma("unroll") for (int n = 0; n < 2; ++n) _Pragma("unroll") for (int k = 0; k < 2; ++k) dst[n][k] = *(const PG8_LAS bf16x8*)(lds + PG8_SB(b, h) + boff + n * 2048 + k * 1024); } while (0)
#define PG8_MMA(ai, bj, At, Bt) do { __builtin_amdgcn_s_setprio(1); _Pragma("unroll") for (int m = 0; m < 4; ++m) _Pragma("unroll") for (int n = 0; n < 2; ++n) _Pragma("unroll") for (int k = 0; k < 2; ++k) \
        acc[ai][bj][m][n] = __builtin_amdgcn_mfma_f32_16x16x32_bf16(Bt[n][k], At[m][k], acc[ai][bj][m][n], 0, 0, 0); __builtin_amdgcn_s_setprio(0); } while (0)
#define PG8_WAIT_V(n) asm volatile("s_waitcnt vmcnt(" #n ")" ::: "memory")
#define PG8_WAIT_L(n) asm volatile("s_waitcnt lgkmcnt(" #n ")" ::: "memory")
#define PG8_BAR __builtin_amdgcn_s_barrier()
#define PG8_SCHED __builtin_amdgcn_sched_barrier(0)
    Unit cur, nxt; int ui = 0;
    if (!S.next(0, cur)) return;
    f32x4 acc[2][2][4][2];
#pragma unroll
    for (int a = 0; a < 2; ++a)
#pragma unroll
        for (int b = 0; b < 2; ++b)
#pragma unroll
            for (int m = 0; m < 4; ++m)
#pragma unroll
                for (int n = 0; n < 2; ++n) acc[a][b][m][n] = (f32x4){0.f, 0.f, 0.f, 0.f};
    bf16x8 At[4][2], B0[2][2], B1[2][2];
    const char* cA = (const char*)g.A + (size_t)cur.pm * tstep; const char* cB = (const char*)g.Bt + (size_t)cur.pn * tstep;
    S.a_ready(cur);
    if constexpr (SP2) {
        PG8_STAGE(PG8_SB(0, 0), cB, voffB); PG8_STAGE(PG8_SB(0, 1), cB + hstep, voffB); PG8_STAGE(PG8_SA(0, 0), cA, voffA); PG8_STAGE(PG8_SA(0, 1), cA + hstep, voffA);
        if (wr == 1) PG8_BAR;
        PG8_WAIT_V(2); PG8_BAR;
        PG8_STAGE(PG8_SB(1, 0), cB + kstep, voffB); PG8_STAGE(PG8_SA(1, 0), cA + kstep, voffA); PG8_STAGE(PG8_SB(1, 1), cB + hstep + kstep, voffB);
        PG8_WAIT_V(6); PG8_BAR;
    } else {
        PG8_STAGE(PG8_SB(0, 0), cB, voffB); PG8_STAGE(PG8_SA(0, 0), cA, voffA); PG8_STAGE(PG8_SB(0, 1), cB + hstep, voffB); PG8_STAGE(PG8_SA(0, 1), cA + hstep, voffA);
        if (wr == 1) PG8_BAR;
        PG8_WAIT_V(4); PG8_BAR;
        PG8_STAGE(PG8_SB(1, 0), cB + kstep, voffB); PG8_STAGE(PG8_SA(1, 0), cA + kstep, voffA); PG8_STAGE(PG8_SB(1, 1), cB + hstep + kstep, voffB);
        PG8_WAIT_V(6); PG8_BAR;
    }
    for (;;) {
        const bool has_next = S.next(ui + 1, nxt);
        const char* nA = has_next ? (const char*)g.A + (size_t)nxt.pm * tstep : cA; const char* nB = has_next ? (const char*)g.Bt + (size_t)nxt.pn * tstep : cB;
        for (int t = 0; t < nt; t += 2) {
            const bool last = (t == nt - 2);
            const char* a1 = cA + (size_t)(t + 1) * kstep;
            const char* a2 = last ? nA : cA + (size_t)(t + 2) * kstep; const char* b2 = last ? nB : cB + (size_t)(t + 2) * kstep;
            const char* a3 = a2 + kstep; const char* b3 = b2 + kstep;
            if (last && has_next) S.a_ready(nxt);
            if constexpr (SP2) {
            PG8_LDB(B0, 0, 0); PG8_LDB(B1, 0, 1); PG8_SCHED; PG8_LDA(At, 0, 0); PG8_STAGE(PG8_SA(1, 1), a1 + hstep, voffA);
            PG8_WAIT_V(8); PG8_WAIT_L(0); PG8_BAR; PG8_MMA(0, 0, At, B0); PG8_MMA(0, 1, At, B1); PG8_BAR; PG8_SCHED;
            PG8_LDA(At, 0, 1); PG8_STAGE(PG8_SB(0, 0), b2, voffB); PG8_STAGE(PG8_SB(0, 1), b2 + hstep, voffB); PG8_STAGE(PG8_SA(0, 0), a2, voffA);
            PG8_WAIT_V(8); PG8_WAIT_L(0); PG8_BAR; PG8_MMA(1, 0, At, B0); PG8_MMA(1, 1, At, B1); PG8_BAR; PG8_SCHED;
            PG8_LDB(B0, 1, 0); PG8_LDB(B1, 1, 1); PG8_SCHED; PG8_LDA(At, 1, 0); PG8_STAGE(PG8_SA(0, 1), a2 + hstep, voffA);
            PG8_WAIT_V(8); PG8_WAIT_L(0); PG8_BAR; PG8_MMA(0, 0, At, B0); PG8_MMA(0, 1, At, B1); PG8_BAR; PG8_SCHED;
            PG8_LDA(At, 1, 1); PG8_STAGE(PG8_SB(1, 0), b3, voffB); PG8_STAGE(PG8_SB(1, 1), b3 + hstep, voffB); PG8_STAGE(PG8_SA(1, 0), a3, voffA);
            PG8_WAIT_V(8); PG8_WAIT_L(0); PG8_BAR; PG8_MMA(1, 0, At, B0); PG8_MMA(1, 1, At, B1); PG8_BAR; PG8_SCHED;
            } else {
            PG8_LDB(B0, 0, 0); PG8_SCHED; PG8_LDA(At, 0, 0); PG8_STAGE(PG8_SA(1, 1), a1 + hstep, voffA);
            PG8_WAIT_L(8); PG8_BAR; PG8_WAIT_L(0); PG8_MMA(0, 0, At, B0); PG8_BAR; PG8_SCHED;
            PG8_LDB(B1, 0, 1); PG8_STAGE(PG8_SB(0, 0), b2, voffB);
            PG8_BAR; PG8_WAIT_L(0); PG8_MMA(0, 1, At, B1); PG8_BAR;
            PG8_LDA(At, 0, 1); PG8_STAGE(PG8_SA(0, 0), a2, voffA);
            PG8_BAR; PG8_WAIT_L(0); PG8_MMA(1, 0, At, B0); PG8_BAR; PG8_SCHED;
            PG8_STAGE(PG8_SB(0, 1), b2 + hstep, voffB);
            PG8_WAIT_V(6); PG8_BAR; PG8_MMA(1, 1, At, B1); PG8_BAR;
            PG8_LDB(B0, 1, 0); PG8_SCHED; PG8_LDA(At, 1, 0); PG8_STAGE(PG8_SA(0, 1), a2 + hstep, voffA);
            PG8_WAIT_L(8); PG8_BAR; PG8_WAIT_L(0); PG8_MMA(0, 0, At, B0); PG8_BAR; PG8_SCHED;
            PG8_LDB(B1, 1, 1); PG8_STAGE(PG8_SB(1, 0), b3, voffB);
            PG8_BAR; PG8_WAIT_L(0); PG8_MMA(0, 1, At, B1); PG8_BAR;
            PG8_LDA(At, 1, 1); PG8_STAGE(PG8_SA(1, 0), a3, voffA);
            PG8_BAR; PG8_WAIT_L(0); PG8_MMA(1, 0, At, B0); PG8_BAR; PG8_SCHED;
            PG8_STAGE(PG8_SB(1, 1), b3 + hstep, voffB);
            PG8_WAIT_V(6); PG8_BAR; PG8_MMA(1, 1, At, B1); PG8_BAR;
            }
        }
        if constexpr (ALIGN_EPI) { if (wr == 0) PG8_BAR; }
        if constexpr (!Epi::AFTER_DRAIN) { E(acc, cur, wr, wc, fr, fq); S.done(cur); }
        if (!has_next) break;
#pragma unroll
        for (int a = 0; a < 2; ++a)
#pragma unroll
            for (int b = 0; b < 2; ++b)
#pragma unroll
                for (int m = 0; m < 4; ++m)
#pragma unroll
                    for (int n = 0; n < 2; ++n) acc[a][b][m][n] = (f32x4){0.f, 0.f, 0.f, 0.f};
        cur = nxt; cA = nA; cB = nB; ++ui;
        if constexpr (ALIGN_EPI) { if (wr == 1) PG8_BAR; }
    }
    PG8_WAIT_V(0);
    if constexpr (!ALIGN_EPI) { if (wr == 0) PG8_BAR; }
    PG8_BAR;
    if constexpr (Epi::AFTER_DRAIN) { E.fused(acc, cur, wr, wc, fr, fq, lds, wid, lane); S.done(cur); }
#undef PG8_SA
#undef PG8_SB
#undef PG8_STAGE
#undef PG8_LDA
#undef PG8_LDB
#undef PG8_MMA
#undef PG8_WAIT_V
#undef PG8_WAIT_L
#undef PG8_BAR
#undef PG8_SCHED
}
}

#define LAS __attribute__((address_space(3)))
typedef unsigned short bf16_t;
typedef unsigned v4u __attribute__((ext_vector_type(4)));
typedef unsigned v2u __attribute__((ext_vector_type(2)));
typedef float f32x4 __attribute__((ext_vector_type(4)));
typedef float f32x16 __attribute__((ext_vector_type(16)));
typedef short bf16x8 __attribute__((ext_vector_type(8)));
typedef short s16x4 __attribute__((ext_vector_type(4)));

constexpr int NWAVES = 8, NTHR = 512;
constexpr int BATCH = 2, SEQ = 8192, DM = 1024, M = BATCH * SEQ;
constexpr int DIN = 1704;
constexpr int NPROJ = 2304;
constexpr int C_QL = 0, C_CKV = 1024, C_IQ = 1152, C_IK = 1408, C_IW = 1440, C_UP = 1448, C_UC = 1704, C_END = 2216;
constexpr int KMIX = 1536;
constexpr int NE = 16, DE = 512;
constexpr int MAXSLOT = 36864;
constexpr float ALPHA = 1.41421356237309515f, LN_EPS = 1e-5f;
constexpr int TOPK = 256;

constexpr size_t MiB = 1u << 20;
constexpr size_t WS_BLKCNT = 0;
constexpr size_t WS_TILETAB = 64 * 1024;
constexpr size_t WS_BAR = 128 * 1024;
constexpr size_t WS_SSQ = 1 * MiB;
constexpr size_t WS_TOKE = 2 * MiB;
constexpr size_t WS_TOKG = 2 * MiB + 256 * 1024;
constexpr size_t WS_TOKS = 2 * MiB + 512 * 1024;
constexpr size_t WS_GSLOT = 3 * MiB;
constexpr size_t WS_WIN = 4 * MiB;
constexpr size_t WS_WO = 9 * MiB;
constexpr size_t WS_WGU = 12 * MiB;
constexpr size_t WS_WD = 44 * MiB;
constexpr size_t WS_XB = 60 * MiB;
constexpr size_t WS_R = 92 * MiB;
constexpr size_t WS_PROJ = WS_R;
constexpr size_t WS_YMIX = WS_R + 72 * MiB;
constexpr size_t WS_XS = WS_R;
constexpr size_t WS_H = WS_R + 72 * MiB;
constexpr size_t WS_IKC = WS_R + 120 * MiB;
constexpr size_t WS_CKVC = WS_R + 121 * MiB;
constexpr size_t WS_END = WS_R + 125 * MiB;

constexpr int LDS_BYTES = 147456;
constexpr int LDS_MISC = 143360;

#define LDS_WAIT() asm volatile("s_waitcnt lgkmcnt(0)" ::: "memory")
#define VM_WAIT() asm volatile("s_waitcnt vmcnt(0)" ::: "memory")

__device__ __forceinline__ unsigned f2bf(float f) { unsigned u = __builtin_bit_cast(unsigned, f); return (u + 0x7fffu + ((u >> 16) & 1u)) >> 16; }
__device__ __forceinline__ unsigned pk2(float lo, float hi) { return f2bf(lo) | (f2bf(hi) << 16); }
__device__ __forceinline__ float bflo(unsigned w) { return __builtin_bit_cast(float, w << 16); }
__device__ __forceinline__ float bfhi(unsigned w) { return __builtin_bit_cast(float, w & 0xffff0000u); }
__device__ __forceinline__ float bf2f(bf16_t v) { return __builtin_bit_cast(float, (unsigned)v << 16); }
__device__ __forceinline__ int ld_agent(const int* p) { return __hip_atomic_load(p, __ATOMIC_RELAXED, __HIP_MEMORY_SCOPE_AGENT); }
__device__ __forceinline__ float ld_agent_f(const float* p) { return __hip_atomic_load(p, __ATOMIC_RELAXED, __HIP_MEMORY_SCOPE_AGENT); }
__device__ __forceinline__ float wave_sum(float v) {
#pragma unroll
    for (int o = 1; o < 64; o <<= 1) v += __shfl_xor(v, o);
    return v;
}
__device__ __forceinline__ float sigmoidf_(float x) { return 1.0f / (1.0f + __expf(-x)); }

#define RLX_AGENT __ATOMIC_RELAXED, __HIP_MEMORY_SCOPE_AGENT
#define XB_TMO      128
#define XB_XCNT(j)  (256  + 64 * (j))
#define XB_XSUB(j)  (1280 + 64 * (j))
#define XB_XGEN(j)  (2304 + 64 * (j))
#define XB_TOP      3328
#define XB_TOPGEN   3392
#define XCD_BAR_WORDS 3456
#define XB_SPIN_CAP (1u << 18)

__device__ __forceinline__ unsigned xb_ld(unsigned* p)              { return __hip_atomic_load(p, __ATOMIC_RELAXED, __HIP_MEMORY_SCOPE_AGENT); }
__device__ __forceinline__ unsigned xb_add(unsigned* p, unsigned v) { return __hip_atomic_fetch_add(p, v, __ATOMIC_RELAXED, __HIP_MEMORY_SCOPE_AGENT); }
__device__ __forceinline__ unsigned xb_xcc_id() { return (unsigned)__builtin_amdgcn_s_getreg((3 << 11) | 20) & 0xFu; }
#define XB_SPIN(cond, bar) do { unsigned _sp = 0; while (cond) { __builtin_amdgcn_s_sleep(1); \
    if ((++_sp & 255u) == 0u) { if (xb_ld(&(bar)[XB_TMO])) break; if (_sp > XB_SPIN_CAP) { atomicAdd(&(bar)[XB_TMO], 1u); break; } } } } while (0)

struct XcdBarrier {
    unsigned* bar; unsigned x;
    volatile LAS unsigned* st;
};

__device__ __forceinline__ XcdBarrier xcd_barrier_post(unsigned* bar, volatile LAS unsigned* st) {
    XcdBarrier b; b.bar = bar; b.x = xb_xcc_id(); b.st = st;
    if (threadIdx.x == 0) (void)xb_add(&bar[XB_XCNT(b.x)], 1u);
    return b;
}
__device__ __forceinline__ void xcd_barrier_complete(unsigned* bar, unsigned x, unsigned& nloc, unsigned& nx) {
    const unsigned G = gridDim.x * gridDim.y * gridDim.z;
    unsigned sum, cnt, mine, sp = 0u;
    for (;;) {
        sum = 0u; cnt = 0u; mine = 0u;
#pragma unroll
        for (unsigned j = 0; j < 16; ++j) { const unsigned c = xb_ld(&bar[XB_XCNT(j)]); sum += c; cnt += (c > 0u) ? 1u : 0u; mine = (j == x) ? c : mine; }
        if (sum == G) break;
        __builtin_amdgcn_s_sleep(1);
        if ((++sp & 255u) == 0u) { if (xb_ld(&bar[XB_TMO])) break; if (sp > XB_SPIN_CAP) { atomicAdd(&bar[XB_TMO], 1u); break; } }
    }
    nloc = mine > 0u ? mine : 1u; nx = cnt > 0u ? cnt : 1u;
}

__device__ __forceinline__ void xcd_barrier(const XcdBarrier& b) {
    asm volatile("s_waitcnt vmcnt(0)" ::: "memory");
    __syncthreads();
    if (threadIdx.x == 0) {
        unsigned* bar = b.bar;
        __builtin_amdgcn_s_waitcnt(0);
        unsigned nloc = b.st[0], nx = b.st[1];
        if (nloc == 0u) { xcd_barrier_complete(bar, b.x, nloc, nx); b.st[0] = nloc; b.st[1] = nx; }
        const unsigned old = xb_add(&bar[XB_XSUB(b.x)], 1u);
        const unsigned gen = old / nloc;
        if (old + 1u == (gen + 1u) * nloc) {
            __builtin_amdgcn_fence(__ATOMIC_RELEASE, "agent");
            asm volatile("s_waitcnt vmcnt(0)" ::: "memory");
            const unsigned og = xb_add(&bar[XB_TOP], 1u);
            const unsigned tg = og / nx;
            if (og + 1u == (tg + 1u) * nx) xb_add(&bar[XB_TOPGEN], 1u);
            else XB_SPIN(xb_ld(&bar[XB_TOPGEN]) == tg, bar);
            __builtin_amdgcn_fence(__ATOMIC_ACQUIRE, "agent");
            xb_add(&bar[XB_XGEN(b.x)], 1u);
            asm volatile("s_waitcnt vmcnt(0)" ::: "memory");
        } else {
            XB_SPIN(xb_ld(&bar[XB_XGEN(b.x)]) == gen, bar);
            __builtin_amdgcn_fence(__ATOMIC_ACQUIRE, "agent");
            asm volatile("s_waitcnt vmcnt(0)" ::: "memory");
        }
    }
    __syncthreads();
}

struct Args {
    const float* in[21]; float* out; unsigned char* ws; int ph_lo, ph_hi, coop, pad;
};

struct Frame {
    LAS unsigned char* lds;
    int tid, lane, wave, G, bid;
};
__device__ __forceinline__ Frame relaunder(const Frame& F) { Frame L = F; int t = threadIdx.x; asm volatile("" : "+v"(t)); L.tid = t; L.lane = t & 63; L.wave = __builtin_amdgcn_readfirstlane(t >> 6); return L; }
typedef const __attribute__((address_space(4))) Args* KArgs;
__device__ __forceinline__ KArgs kargs() { KArgs p = (KArgs)__builtin_amdgcn_kernarg_segment_ptr(); asm volatile("" : "+s"(p)); return p; }
struct LayerW {
    const float *w_in, *kvg, *w_uk, *w_uv, *w_o, *w_gate, *w_up, *w_down;
};
__device__ __forceinline__ bf16_t* ws_bf(KArgs A, size_t off) { return (bf16_t*)(A->ws + off); }

struct EpiProj {
    static constexpr bool PERM = false, AFTER_DRAIN = false;
    bf16_t* O; float* ssq; bf16_t* ikc; bf16_t* ckvc;
    __device__ __forceinline__ void operator()(const f32x4 (&acc)[2][2][4][2], const pg8::Unit& u, int wr, int wc, int fr, int fq) const {
        const int col0 = u.pn * 256 + wc * 32 + 4 * fq;
#pragma unroll
        for (int ai = 0; ai < 2; ++ai)
#pragma unroll
            for (int m = 0; m < 4; ++m) {
                const int row = u.pm * 256 + ai * 128 + wr * 64 + m * 16 + fr;
                bf16_t* rowp = O + (size_t)row * NPROJ + col0;
#pragma unroll
                for (int bj = 0; bj < 2; ++bj)
#pragma unroll
                    for (int n = 0; n < 2; ++n) { const f32x4 v = acc[ai][bj][m][n]; v2u w; w.x = pk2(v[0], v[1]); w.y = pk2(v[2], v[3]); *(v2u*)(rowp + bj * 128 + n * 16) = w; }
                if (u.pn == 4) {
                    float ss = 0.f;
#pragma unroll
                    for (int n = 0; n < 2; ++n) { const f32x4 v = acc[ai][0][m][n]; ss += (v[0] * v[0] + v[1] * v[1]) + (v[2] * v[2] + v[3] * v[3]); }
                    ss += __shfl_xor(ss, 16); ss += __shfl_xor(ss, 32);
                    if (fq == 0) ssq[(size_t)row * 4 + wc] = ss;
#pragma unroll
                    for (int n = 0; n < 2; ++n) { const f32x4 v = acc[ai][0][m][n]; v2u w; w.x = pk2(v[0], v[1]); w.y = pk2(v[2], v[3]); *(v2u*)(ckvc + (size_t)row * 128 + wc * 32 + n * 16 + 4 * fq) = w; }
                }
                if (u.pn == 5 && wc == 0) {
#pragma unroll
                    for (int n = 0; n < 2; ++n) { const f32x4 v = acc[ai][1][m][n]; v2u w; w.x = pk2(v[0], v[1]); w.y = pk2(v[2], v[3]); *(v2u*)(ikc + (size_t)row * 32 + n * 16 + 4 * fq) = w; }
                }
            }
    }
};
struct EpiMix {
    static constexpr bool PERM = false, AFTER_DRAIN = false;
    const float* base; float* out;
    __device__ __forceinline__ void operator()(const f32x4 (&acc)[2][2][4][2], const pg8::Unit& u, int wr, int wc, int fr, int fq) const {
        const int col0 = u.pn * 256 + wc * 32 + 4 * fq;
#pragma unroll
        for (int ai = 0; ai < 2; ++ai)
#pragma unroll
            for (int m = 0; m < 4; ++m) {
                const size_t off = (size_t)(u.pm * 256 + ai * 128 + wr * 64 + m * 16 + fr) * DM + col0;
#pragma unroll
                for (int bj = 0; bj < 2; ++bj)
#pragma unroll
                    for (int n = 0; n < 2; ++n) { const f32x4 b = *(const f32x4*)(base + off + bj * 128 + n * 16); *(f32x4*)(out + off + bj * 128 + n * 16) = b * ALPHA + acc[ai][bj][m][n]; }
                asm volatile("" ::: "memory");
            }
    }
};
struct EpiGU {
    static constexpr bool PERM = false, AFTER_DRAIN = false;
    bf16_t* H; const float* gslot;
    __device__ __forceinline__ void operator()(const f32x4 (&acc)[2][2][4][2], const pg8::Unit& u, int wr, int wc, int fr, int fq) const {
        const int f0 = (u.pn & 3) * 128 + wc * 16 + 4 * fq;
#pragma unroll
        for (int ai = 0; ai < 2; ++ai)
#pragma unroll
            for (int m = 0; m < 4; ++m) {
                const int row = u.pm * 256 + ai * 128 + wr * 64 + m * 16 + fr;
                const float gw = gslot[row];
#pragma unroll
                for (int bj = 0; bj < 2; ++bj) {
                    const f32x4 g = acc[ai][bj][m][0], up = acc[ai][bj][m][1]; float h[4];
#pragma unroll
                    for (int i = 0; i < 4; ++i) h[i] = g[i] * sigmoidf_(g[i]) * up[i] * gw;
                    v2u w; w.x = pk2(h[0], h[1]); w.y = pk2(h[2], h[3]); *(v2u*)(H + (size_t)row * DE + f0 + bj * 64) = w;
                }
                asm volatile("" ::: "memory");
            }
    }
};
struct EpiDown {
    static constexpr bool PERM = false, AFTER_DRAIN = false;
    bf16_t* Y;
    __device__ __forceinline__ void operator()(const f32x4 (&acc)[2][2][4][2], const pg8::Unit& u, int wr, int wc, int fr, int fq) const {
        const int col0 = (u.pn & 3) * 256 + wc * 32 + 4 * fq;
#pragma unroll
        for (int ai = 0; ai < 2; ++ai)
#pragma unroll
            for (int m = 0; m < 4; ++m) {
                bf16_t* rowp = Y + (size_t)(u.pm * 256 + ai * 128 + wr * 64 + m * 16 + fr) * DM + col0;
#pragma unroll
                for (int bj = 0; bj < 2; ++bj)
#pragma unroll
                    for (int n = 0; n < 2; ++n) { const f32x4 v = acc[ai][bj][m][n]; v2u w; w.x = pk2(v[0], v[1]); w.y = pk2(v[2], v[3]); *(v2u*)(rowp + bj * 128 + n * 16) = w; }
            }
    }
};
struct GroupedOrder {
    const int* tab; int G, c, nunits;
    __device__ __forceinline__ void init(const int* tab_, int G_, int c_) { tab = tab_; G = G_; c = c_; nunits = ld_agent(tab_) * 4; }
    __device__ __forceinline__ bool next(int i, pg8::Unit& u) const {
        const int L = i * G + c; if (L >= nunits) return false;
        const int pm = L >> 2; const int e = ld_agent(tab + 1 + pm); u.pm = pm; u.pn = e * 4 + (L & 3); return true;
    }
    __device__ __forceinline__ void a_ready(const pg8::Unit&) const {}
    __device__ __forceinline__ void done(const pg8::Unit&) const {}
};

struct RowId { __device__ __forceinline__ int operator()(int n) const { return n; } };
struct RowGU { int up; __device__ __forceinline__ int operator()(int n) const { return 32 * (n >> 4) + (n & 15) + 16 * up; } };

template <class RM>
__device__ __forceinline__ void transpose_item(const float* W, int ldw, int krow0, int col0, int ncols, bf16_t* WT, int pitch, int koff, RM rm, LAS float* scr, int item, int lane) {
    const int nblk = (ncols + 31) >> 5, kb = item / nblk, nb = item - kb * nblk, k0 = 64 * kb, n0 = 32 * nb;
    const int nl = lane & 31; const bool nv = (n0 + nl) < ncols;
#pragma unroll 8
    for (int i = 0; i < 32; ++i) { const int kk = 2 * i + (lane >> 5); scr[kk * 33 + nl] = nv ? W[(size_t)(krow0 + k0 + kk) * ldw + col0 + n0 + nl] : 0.f; }
    LDS_WAIT();
    const int c = lane & 7;
#pragma unroll
    for (int j = 0; j < 4; ++j) { const int nn = (lane >> 3) + 8 * j; const LAS float* s = scr + (8 * c) * 33 + nn;
        if (n0 + nn < ncols) { v4u o; o.x = pk2(s[0 * 33], s[1 * 33]); o.y = pk2(s[2 * 33], s[3 * 33]); o.z = pk2(s[4 * 33], s[5 * 33]); o.w = pk2(s[6 * 33], s[7 * 33]);
            *(v4u*)(WT + (size_t)rm(n0 + nn) * pitch + koff + k0 + 8 * c) = o; } }
    LDS_WAIT();
}

__device__ __forceinline__ void absorb_q_task(const Frame& F, const float* w_in, const float* w_uk, const float* kvg, bf16_t* Win_t, int a) {
    const int h = a >> 6, kb = (a >> 2) & 15, rq = a & 3, k = kb * 64 + F.lane;
    f32x4 win[16];
    const f32x4* src = (const f32x4*)(w_in + (size_t)k * DIN + h * 64);
#pragma unroll
    for (int i = 0; i < 16; ++i) win[i] = src[i];
#pragma unroll 1
    for (int r = rq * 32; r < rq * 32 + 32; ++r) {
        const f32x4* wu = (const f32x4*)(w_uk + (size_t)(h * 128 + r) * 64);
        float acc = 0.f;
#pragma unroll
        for (int i = 0; i < 16; ++i) { const f32x4 u = wu[i]; acc += win[i][0] * u[0]; acc += win[i][1] * u[1]; acc += win[i][2] * u[2]; acc += win[i][3] * u[3]; }
        Win_t[(size_t)(h * 128 + r) * DM + k] = (bf16_t)f2bf(acc * 0.125f * kvg[r]);
    }
}
__device__ __forceinline__ void absorb_o_task(const Frame& F, const float* w_o, const float* w_uv, const float* kvg, bf16_t* Wo_t, int a) {
    const int h = a >> 6, nb = (a >> 2) & 15, rq = a & 3, n = nb * 64 + F.lane;
    float wo[64];
#pragma unroll
    for (int d = 0; d < 64; ++d) wo[d] = w_o[(size_t)(h * 64 + d) * DM + n];
#pragma unroll 1
    for (int r = rq * 32; r < rq * 32 + 32; ++r) {
        const f32x4* wu = (const f32x4*)(w_uv + (size_t)(h * 128 + r) * 64);
        float s = 0.f;
#pragma unroll
        for (int i = 0; i < 16; ++i) { const f32x4 u = wu[i]; s += wo[4 * i] * u[0]; s += wo[4 * i + 1] * u[1]; s += wo[4 * i + 2] * u[2]; s += wo[4 * i + 3] * u[3]; }
        Wo_t[(size_t)n * KMIX + h * 128 + r] = (bf16_t)f2bf(s * kvg[r]);
    }
}

__device__ __forceinline__ void phase_convert(const Frame& F0, int l, bool with_x) {
    const Frame F = relaunder(F0);
    KArgs A = kargs();
    const float* w_in = A->in[1] + (size_t)l * DM * DIN; const float* kvg = A->in[2] + l * 128;
    const float* w_uk = A->in[3] + (size_t)l * 8 * 128 * 64; const float* w_uv = A->in[4] + (size_t)l * 8 * 128 * 64;
    const float* w_o = A->in[11] + (size_t)l * DM * DM;
    const float* w_gate = A->in[16] + (size_t)l * NE * DM * DE; const float* w_up = A->in[17] + (size_t)l * NE * DM * DE; const float* w_down = A->in[18] + (size_t)l * NE * DE * DM;
    bf16_t* Win_t = ws_bf(A, WS_WIN); bf16_t* Wo_t = ws_bf(A, WS_WO); bf16_t* Wgu_t = ws_bf(A, WS_WGU); bf16_t* Wd_t = ws_bf(A, WS_WD);
    LAS float* scr = (LAS float*)(F.lds + F.wave * 16384);
    const int gw = F.bid * NWAVES + F.wave, NGW = F.G * NWAVES;
    constexpr int I_AQ = 512, I_AO = 512, I_IN = 16 * 38, I_O2 = 8 * 32, I_G1 = 256, I_D1 = 256, I_Z = 88;
    constexpr int NITEMS = I_AQ + I_AO + I_IN + I_O2 + NE * (2 * I_G1 + I_D1) + I_Z;
#pragma unroll 1
    for (int it = gw; it < NITEMS; it += NGW) {
        int r = it;
#ifndef NO_AQ
        if (r < I_AQ) { absorb_q_task(F, w_in, w_uk, kvg, Win_t, r); continue; }
#endif
        r -= I_AQ;
#ifndef NO_AO
        if (r < I_AO) { absorb_o_task(F, w_o, w_uv, kvg, Wo_t, r); continue; }
#endif
        r -= I_AO;
        if (r < I_IN) { transpose_item(w_in, DIN, 0, 512, DIN - 512, Win_t + (size_t)1024 * DM, DM, 0, RowId{}, scr, r, F.lane); continue; } r -= I_IN;
        if (r < I_O2) { transpose_item(w_o, DM, 512, 0, DM, Wo_t, KMIX, 1024, RowId{}, scr, r, F.lane); continue; } r -= I_O2;
        if (r < NE * 2 * I_G1) { const int e = r / (2 * I_G1), q = r % (2 * I_G1), up = q / I_G1, item = q % I_G1;
            transpose_item((up ? w_up : w_gate) + (size_t)e * DM * DE, DE, 0, 0, DE, Wgu_t + (size_t)e * 1024 * DM, DM, 0, RowGU{up}, scr, item, F.lane); continue; } r -= NE * 2 * I_G1;
        if (r < NE * I_D1) { const int e = r / I_D1, item = r % I_D1;
            transpose_item(w_down + (size_t)e * DE * DM, DM, 0, 0, DM, Wd_t + (size_t)e * 1024 * DE, DE, 0, RowId{}, scr, item, F.lane); continue; } r -= NE * I_D1;
        { v4u z = {0u, 0u, 0u, 0u}; v4u* p = (v4u*)(Win_t + (size_t)(C_END + r) * DM); p[F.lane] = z; p[F.lane + 64] = z; }
    }
    if (with_x) {
        const float* x = A->in[0]; bf16_t* xb = ws_bf(A, WS_XB);
#pragma unroll 1
        for (int m = gw; m < M; m += NGW) {
            const f32x4* xr = (const f32x4*)(x + (size_t)m * DM) + F.lane; v2u* o = (v2u*)(xb + (size_t)m * DM) + F.lane;
#pragma unroll
            for (int j = 0; j < 4; ++j) { const f32x4 v = xr[64 * j]; v2u w; w.x = pk2(v[0], v[1]); w.y = pk2(v[2], v[3]); o[64 * j] = w; }
        }
    }
}

struct MixP { const bf16_t* proj; const bf16_t* ikc; const bf16_t* ckvc; bf16_t* ymix; const float *ssq, *conv_w, *conv_b, *cln_g, *cln_b, *w_pool, *pool_scale; };
__device__ __forceinline__ void conv_pool_tile(const Frame& F, const MixP& P, int tile) {
    const int tid = F.tid, lane = F.lane, wave = F.wave;
    const int row0 = tile * 32;
    const int tpos0 = row0 & (SEQ - 1);
    LAS float* hbuf = (LAS float*)F.lds;
#pragma unroll 1
    for (int task = tid; task < 62 * 32; task += NTHR) {
        const int j = task >> 5, c8 = (task & 31) * 8; const int tp = tpos0 - 30 + j;
        f32x4 h0 = {0.f, 0.f, 0.f, 0.f}, h1 = {0.f, 0.f, 0.f, 0.f};
        if (tp >= 0) {
            const bf16_t* p = P.proj + (size_t)(row0 - 30 + j) * NPROJ + C_UC + c8;
            const v4u a = *(const v4u*)p, g = *(const v4u*)(p + 256);
            h0[0] = bflo(a.x) * sigmoidf_(bflo(g.x)); h0[1] = bfhi(a.x) * sigmoidf_(bfhi(g.x)); h0[2] = bflo(a.y) * sigmoidf_(bflo(g.y)); h0[3] = bfhi(a.y) * sigmoidf_(bfhi(g.y));
            h1[0] = bflo(a.z) * sigmoidf_(bflo(g.z)); h1[1] = bfhi(a.z) * sigmoidf_(bfhi(g.z)); h1[2] = bflo(a.w) * sigmoidf_(bflo(g.w)); h1[3] = bfhi(a.w) * sigmoidf_(bfhi(g.w));
        }
        *(LAS f32x4*)(hbuf + j * 256 + c8) = h0; *(LAS f32x4*)(hbuf + j * 256 + c8 + 4) = h1;
    }
    __syncthreads();
    if (tid < 256) {
        const int c = tid; float w[31];
#pragma unroll
        for (int j = 0; j < 31; ++j) w[j] = P.conv_w[j * 256 + c];
        const float bias = P.conv_b[c];
#pragma unroll 1
        for (int t = 31; t >= 0; --t) {
            float acc = bias;
#pragma unroll
            for (int j = 0; j < 31; ++j) acc += hbuf[(t + j) * 256 + c] * w[j];
            hbuf[(t + 30) * 256 + c] = acc;
        }
    }
    __syncthreads();
#pragma unroll 1
    for (int i = wave; i < 32; i += NWAVES) {
        const f32x4 x = *(LAS f32x4*)(hbuf + (i + 30) * 256 + 4 * lane);
        const float mean = wave_sum((x[0] + x[1]) + (x[2] + x[3])) * (1.f / 256.f);
        const f32x4 d = x - mean;
        const float var = wave_sum((d[0] * d[0] + d[1] * d[1]) + (d[2] * d[2] + d[3] * d[3])) * (1.f / 256.f);
        const float rstd = 1.0f / sqrtf(var + LN_EPS);
        const f32x4 g = *(const f32x4*)(P.cln_g + 4 * lane), b = *(const f32x4*)(P.cln_b + 4 * lane);
        float y[4];
#pragma unroll
        for (int k = 0; k < 4; ++k) { const float z = d[k] * rstd * g[k] + b[k]; y[k] = z * sigmoidf_(z); }
        v2u w; w.x = pk2(y[0], y[1]); w.y = pk2(y[2], y[3]);
        *(v2u*)(P.ymix + (size_t)(row0 + i) * KMIX + 1280 + 4 * lane) = w;
    }
    __syncthreads();
    LAS float* pbuf = (LAS float*)F.lds; LAS float* plbuf = (LAS float*)(F.lds + 49152);
#pragma unroll 1
    for (int task = tid; task < 47 * 32; task += NTHR) {
        const int j = task >> 5, c8 = (task & 31) * 8; const int tp = tpos0 - 15 + j;
        f32x4 h0 = {0.f, 0.f, 0.f, 0.f}, h1 = {0.f, 0.f, 0.f, 0.f};
        if (tp >= 0) {
            const v4u a = *(const v4u*)(P.proj + (size_t)(row0 - 15 + j) * NPROJ + C_UP + c8);
            h0[0] = bflo(a.x); h0[1] = bfhi(a.x); h0[2] = bflo(a.y); h0[3] = bfhi(a.y); h1[0] = bflo(a.z); h1[1] = bfhi(a.z); h1[2] = bflo(a.w); h1[3] = bfhi(a.w);
        }
        *(LAS f32x4*)(pbuf + j * 256 + c8) = h0; *(LAS f32x4*)(pbuf + j * 256 + c8 + 4) = h1;
    }
    __syncthreads();
    {
        const int c = tid & 255, half = tid >> 8, gi = c >> 6, w = 2 << gi;
#pragma unroll 1
        for (int i = 0; i < 16; ++i) {
            const int t = half * 16 + i; float s = 0.f;
            for (int j = 0; j < w; ++j) s += pbuf[(t + 15 - j) * 256 + c];
            const int tp = tpos0 + t; const float cnt = (float)((tp + 1) < w ? (tp + 1) : w);
            plbuf[t * 256 + c] = s / cnt - pbuf[(t + 15) * 256 + c];
        }
    }
    __syncthreads();
    {
        const int dall = tid & 255, half = tid >> 8, g = dall >> 6, d = dall & 63;
        float acc[16];
#pragma unroll
        for (int i = 0; i < 16; ++i) acc[i] = 0.f;
        const float* wp = P.w_pool + (size_t)g * 64 * 64 + d;
#pragma unroll 2
        for (int c = 0; c < 64; ++c) {
            const float wv = wp[c * 64];
#pragma unroll
            for (int i = 0; i < 16; ++i) acc[i] += plbuf[(half * 16 + i) * 256 + g * 64 + c] * wv;
        }
        const float sc = P.pool_scale[dall];
#pragma unroll
        for (int i = 0; i < 16; ++i) P.ymix[(size_t)(row0 + half * 16 + i) * KMIX + 1024 + dall] = (bf16_t)f2bf(acc[i] * sc);
    }
    __syncthreads();
}

__device__ __forceinline__ unsigned f2ord(float f) { const int x = __builtin_bit_cast(int, f); return (unsigned)x ^ ((unsigned)(x >> 31) | 0x80000000u); }
__device__ __forceinline__ float relu_i(float x) { const int i = __builtin_bit_cast(int, x); return __builtin_bit_cast(float, i > 0 ? i : 0); }

__device__ __forceinline__ void hist_scan(LAS unsigned* h, unsigned need, int lane, int& bin, unsigned& above, unsigned& binc) {
    const v4u c = *(LAS v4u*)(h + 4 * lane);
    const unsigned T = c.x + c.y + c.z + c.w;
    unsigned X = T;
#pragma unroll
    for (int o = 1; o < 64; o <<= 1) { const unsigned y = __shfl_down(X, o); if (lane + o < 64) X += y; }
    const unsigned long long mk = __ballot(X >= need);
    const int L = mk ? (63 - __clzll(mk)) : 0;
    const unsigned S3 = X - T + c.w, S2 = S3 + c.z, S1 = S2 + c.y;
    int bl; unsigned ab, bc;
    if (S3 >= need) { bl = 3; ab = X - T; bc = c.w; } else if (S2 >= need) { bl = 2; ab = S3; bc = c.z; } else if (S1 >= need) { bl = 1; ab = S2; bc = c.y; } else { bl = 0; ab = S1; bc = c.x; }
    bin = __shfl(4 * lane + bl, L); above = (unsigned)__shfl((int)ab, L); binc = (unsigned)__shfl((int)bc, L);
}
__device__ __forceinline__ void hist_scan512(LAS unsigned* h, unsigned need, int lane, int& bin, unsigned& above, unsigned& binc) {
    const v4u c0 = *(LAS v4u*)(h + 8 * lane), c1 = *(LAS v4u*)(h + 8 * lane + 4);
    const unsigned cc[8] = {c0.x, c0.y, c0.z, c0.w, c1.x, c1.y, c1.z, c1.w};
    const unsigned T = ((c0.x + c0.y) + (c0.z + c0.w)) + ((c1.x + c1.y) + (c1.z + c1.w));
    unsigned X = T;
#pragma unroll
    for (int o = 1; o < 64; o <<= 1) { const unsigned y = __shfl_down(X, o); if (lane + o < 64) X += y; }
    const unsigned long long mk = __ballot(X >= need);
    const int L = mk ? (63 - __clzll(mk)) : 0;
    unsigned S = X - T; int bl = 0; unsigned ab = S, bc = 0u; bool found = false;
#pragma unroll
    for (int k = 7; k >= 0; --k) { const unsigned Sn = S + cc[k]; if (!found && Sn >= need) { found = true; bl = k; ab = S; bc = cc[k]; } S = Sn; }
    bin = __shfl(8 * lane + bl, L); above = (unsigned)__shfl((int)ab, L); binc = (unsigned)__shfl((int)bc, L);
}

__device__ __forceinline__ int swz16(int row) { return ((row & 3) << 2) | ((row >> 2) & 3); }

constexpr int CAND_CAP = 256;
constexpr int WPRIV = 12800;
#ifndef REP_IDX
#define REP_IDX 0
#endif
#ifndef REP_ATT
#define REP_ATT 0
#endif
#ifndef ABL_FLAGS
#define ABL_FLAGS 0
#endif

struct IdxState {
    unsigned prefix0, prefix1, need0, need1;
    unsigned eqt0, eqt1, cnt0, cnt1, cc0, cc1;
    unsigned blo0, blo1;
    float inv0, inv1, c00, c01;
    float ss0[8], ss1[8];
};
struct IdxConst {
    bf16x8 A0, A1; float wq[2][8]; int tqj0, tqj1; int hh, kl, rd0, rd1;
    LAS unsigned* hist; LAS unsigned short* sel; LAS unsigned* cand_u; LAS unsigned short* cand_i;
    int shift; unsigned himask; int abl;
};
__device__ __forceinline__ unsigned lin_bin(float s, float inv, float c0) { return (unsigned)__builtin_amdgcn_fmed3f(fmaf(s, inv, c0), 0.f, 511.f); }

__device__ __forceinline__ void tile_scores(const IdxConst& C, const f32x16& acc, float& s0, float& s1) {
    float a0 = C.wq[0][0] * relu_i(acc[0]), b0 = C.wq[0][4] * relu_i(acc[4]), a1 = C.wq[1][0] * relu_i(acc[8]), b1 = C.wq[1][4] * relu_i(acc[12]);
#pragma unroll
    for (int h = 1; h < 4; ++h) { a0 = fmaf(C.wq[0][h], relu_i(acc[h]), a0); b0 = fmaf(C.wq[0][4 + h], relu_i(acc[4 + h]), b0); a1 = fmaf(C.wq[1][h], relu_i(acc[8 + h]), a1); b1 = fmaf(C.wq[1][4 + h], relu_i(acc[12 + h]), b1); }
    s0 = (a0 + b0) + 0.0f; s1 = (a1 + b1) + 0.0f;
}
template <int MODE>
__device__ __forceinline__ void tile_post(const IdxConst& C, IdxState& S, const f32x16& acc, int tile, int tl) {
    float s0, s1; tile_scores(C, acc, s0, s1);
    const int kidx = tile * 32 + C.kl;
    const bool v0 = kidx <= C.tqj0, v1 = kidx <= C.tqj1;
    const int hh = C.hh;
    if constexpr (MODE == 6) { S.ss0[tl] = s0; S.ss1[tl] = s1; }
    else if constexpr (MODE == 7) {
        const unsigned b0 = lin_bin(s0, S.inv0, S.c00), b1 = lin_bin(s1, S.inv1, S.c01);
        if (!(C.abl & 1)) {
        if (v0 && b0 >= S.blo0) __hip_atomic_fetch_add(C.hist + (2 * hh) * 512 + b0, 1u, __ATOMIC_RELAXED, __HIP_MEMORY_SCOPE_WORKGROUP);
        if (v1 && b1 >= S.blo1) __hip_atomic_fetch_add(C.hist + (2 * hh + 1) * 512 + b1, 1u, __ATOMIC_RELAXED, __HIP_MEMORY_SCOPE_WORKGROUP);
        } else { asm volatile("" :: "v"(b0), "v"(b1)); }
    } else if constexpr (MODE == 8) {
        if (C.abl & 2) { asm volatile("" :: "v"(s0), "v"(s1)); return; }
        const unsigned b0 = lin_bin(s0, S.inv0, S.c00), b1 = lin_bin(s1, S.inv1, S.c01);
        const unsigned ltm = (1u << C.kl) - 1u;
        {   const bool eq = v0 && (b0 == S.prefix0), gt = v0 && (b0 > S.prefix0);
            const unsigned long long mt = __ballot(gt); const unsigned t32 = hh ? (unsigned)(mt >> 32) : (unsigned)mt;
            const unsigned pos = S.cnt0 + __popc(t32 & ltm); if (gt && pos < TOPK) C.sel[(2 * hh) * 256 + pos] = (unsigned short)kidx; S.cnt0 += __popc(t32);
            const unsigned long long me = __ballot(eq); const unsigned m32 = hh ? (unsigned)(me >> 32) : (unsigned)me;
            const unsigned cp = S.cc0 + __popc(m32 & ltm); if (eq && cp < CAND_CAP) { C.cand_u[(2 * hh) * CAND_CAP + cp] = f2ord(s0); C.cand_i[(2 * hh) * CAND_CAP + cp] = (unsigned short)kidx; } S.cc0 += __popc(m32); }
        {   const bool eq = v1 && (b1 == S.prefix1), gt = v1 && (b1 > S.prefix1);
            const unsigned long long mt = __ballot(gt); const unsigned t32 = hh ? (unsigned)(mt >> 32) : (unsigned)mt;
            const unsigned pos = S.cnt1 + __popc(t32 & ltm); if (gt && pos < TOPK) C.sel[(2 * hh + 1) * 256 + pos] = (unsigned short)kidx; S.cnt1 += __popc(t32);
            const unsigned long long me = __ballot(eq); const unsigned m32 = hh ? (unsigned)(me >> 32) : (unsigned)me;
            const unsigned cp = S.cc1 + __popc(m32 & ltm); if (eq && cp < CAND_CAP) { C.cand_u[(2 * hh + 1) * CAND_CAP + cp] = f2ord(s1); C.cand_i[(2 * hh + 1) * CAND_CAP + cp] = (unsigned short)kidx; } S.cc1 += __popc(m32); }
    } else if constexpr (MODE == 0) {
        const unsigned u0 = f2ord(s0), u1 = f2ord(s1);
        if (v0 && ((u0 & C.himask) == S.prefix0)) __hip_atomic_fetch_add(C.hist + (2 * hh) * 256 + ((u0 >> C.shift) & 255u), 1u, __ATOMIC_RELAXED, __HIP_MEMORY_SCOPE_WORKGROUP);
        if (v1 && ((u1 & C.himask) == S.prefix1)) __hip_atomic_fetch_add(C.hist + (2 * hh + 1) * 256 + ((u1 >> C.shift) & 255u), 1u, __ATOMIC_RELAXED, __HIP_MEMORY_SCOPE_WORKGROUP);
    } else {
        const unsigned u0 = f2ord(s0), u1 = f2ord(s1);
        const unsigned ltm = (1u << C.kl) - 1u;
        {   const bool eq = v0 && (u0 == S.prefix0), gt = v0 && (u0 > S.prefix0);
            const unsigned long long me = __ballot(eq); const unsigned m32 = hh ? (unsigned)(me >> 32) : (unsigned)me;
            const bool take = gt || (eq && (S.eqt0 + __popc(m32 & ltm) < S.need0)); S.eqt0 += __popc(m32);
            const unsigned long long mt = __ballot(take); const unsigned t32 = hh ? (unsigned)(mt >> 32) : (unsigned)mt;
            const unsigned pos = S.cnt0 + __popc(t32 & ltm); if (take && pos < TOPK) C.sel[(2 * hh) * 256 + pos] = (unsigned short)kidx; S.cnt0 += __popc(t32); }
        {   const bool eq = v1 && (u1 == S.prefix1), gt = v1 && (u1 > S.prefix1);
            const unsigned long long me = __ballot(eq); const unsigned m32 = hh ? (unsigned)(me >> 32) : (unsigned)me;
            const bool take = gt || (eq && (S.eqt1 + __popc(m32 & ltm) < S.need1)); S.eqt1 += __popc(m32);
            const unsigned long long mt = __ballot(take); const unsigned t32 = hh ? (unsigned)(mt >> 32) : (unsigned)mt;
            const unsigned pos = S.cnt1 + __popc(t32 & ltm); if (take && pos < TOPK) C.sel[(2 * hh + 1) * 256 + pos] = (unsigned short)kidx; S.cnt1 += __popc(t32); }
    }
}
__device__ __forceinline__ f32x16 tile_mfma(const IdxConst& C, LAS unsigned char* buf, int tl) {
    const bf16x8 B0 = *(LAS bf16x8*)(buf + tl * 2048 + C.rd0), B1 = *(LAS bf16x8*)(buf + tl * 2048 + C.rd1);
    f32x16 a = {0.f, 0.f, 0.f, 0.f, 0.f, 0.f, 0.f, 0.f, 0.f, 0.f, 0.f, 0.f, 0.f, 0.f, 0.f, 0.f};
    a = __builtin_amdgcn_mfma_f32_32x32x16_bf16(C.A0, B0, a, 0, 0, 0);
    return __builtin_amdgcn_mfma_f32_32x32x16_bf16(C.A1, B1, a, 0, 0, 0);
}
template <int MODE>
__device__ __forceinline__ void idx_sweep(const IdxConst& C, IdxState& S, LAS unsigned char* ikbuf, const bf16_t* ikb, int tid, int ntile, int nchunk, int nkeys, int sstride) {
    constexpr bool sample = (MODE == 6);
    const int sr0 = tid >> 2, sc = tid & 3;
    const int sdst0 = sr0 * 64 + ((sc ^ ((sr0 >> 2) & 3)) * 16), sdst1 = (sr0 + 128) * 64 + ((sc ^ (((sr0 + 128) >> 2) & 3)) * 16);
    const int nch = sample ? 1 : nchunk;
    v4u sa = {0u, 0u, 0u, 0u}, sb = {0u, 0u, 0u, 0u};
    {   const int ka = sample ? ((sr0 >> 5) * sstride * 32 + (sr0 & 31)) : sr0, kb = sample ? ((((sr0 + 128) >> 5) * sstride) * 32 + (sr0 & 31)) : (sr0 + 128);
        if (ka < nkeys) sa = *(const v4u*)(ikb + (size_t)ka * 32 + sc * 8);
        if (kb < nkeys) sb = *(const v4u*)(ikb + (size_t)kb * 32 + sc * 8); }
    *(LAS v4u*)(ikbuf + sdst0) = sa; *(LAS v4u*)(ikbuf + sdst1) = sb;
    __syncthreads();
#pragma unroll 1
    for (int ci = 0; ci < nch; ++ci) {
        const bool more = (ci + 1) < nch;
        if (more) { const int k0 = (ci + 1) * 256;
            sa = (v4u){0u, 0u, 0u, 0u}; sb = sa;
            if (k0 + sr0 < nkeys) sa = *(const v4u*)(ikb + (size_t)(k0 + sr0) * 32 + sc * 8);
            if (k0 + sr0 + 128 < nkeys) sb = *(const v4u*)(ikb + (size_t)(k0 + sr0 + 128) * 32 + sc * 8); }
        LAS unsigned char* buf = ikbuf + (ci & 1) * 16384;
        f32x16 accA = tile_mfma(C, buf, 0), accB;
#pragma unroll
        for (int tl = 0; tl < 8; tl += 2) {
            accB = tile_mfma(C, buf, tl + 1);
            tile_post<MODE>(C, S, accA, ci * 8 + tl, tl);
            if (tl + 2 < 8) accA = tile_mfma(C, buf, tl + 2);
            tile_post<MODE>(C, S, accB, ci * 8 + tl + 1, tl + 1);
        }
        if (more) { LAS unsigned char* nb = ikbuf + ((ci + 1) & 1) * 16384; *(LAS v4u*)(nb + sdst0) = sa; *(LAS v4u*)(nb + sdst1) = sb; }
        __syncthreads();
    }
}

__device__ __forceinline__ void dsa_group(const Frame& F, const MixP& P, int b, int t0) {
    const int lane = F.lane, w = F.wave, hh = lane >> 5, kl = lane & 31, tid = F.tid;
    LAS unsigned char* ikbuf = F.lds;
    LAS unsigned char* wl = F.lds + 32768 + w * WPRIV;
    LAS unsigned short* sel = (LAS unsigned short*)wl;
    LAS unsigned* hist = (LAS unsigned*)(wl + 2048);
    LAS unsigned char* cbuf = wl + 2048;
    LAS unsigned* cand_u = (LAS unsigned*)(wl + 2048);
    LAS unsigned short* cand_i = (LAS unsigned short*)(wl + 2048 + 4096);
    LAS bf16_t* obuf = (LAS bf16_t*)(wl + 10240);
    LAS float* rsbuf = (LAS float*)(wl + 12288);
    LAS unsigned* flag = (LAS unsigned*)(F.lds + LDS_MISC + 256);
    const bf16_t* projb = P.proj + (size_t)b * SEQ * NPROJ;
    const bf16_t* ikb = P.ikc + (size_t)b * SEQ * 32;
    const bf16_t* ckvb = P.ckvc + (size_t)b * SEQ * 128;
    const float* ssqb = P.ssq + (size_t)b * SEQ * 4;
    const int tq0 = t0 + 4 * w;

    for (int repi = 0; repi < 1 + REP_IDX; ++repi)
    if (t0 >= TOPK) {
        IdxConst C; IdxState S;
        C.abl = (repi < REP_IDX) ? ABL_FLAGS : 0;
        { const int r = kl, qa = 2 * ((r >> 2) & 1) + (r >> 4), head = (r & 3) + 4 * ((r >> 3) & 1);
          const bf16_t* ap = projb + (size_t)(tq0 + qa) * NPROJ + C_IQ + head * 32 + 8 * hh;
          C.A0 = *(const bf16x8*)ap; C.A1 = *(const bf16x8*)(ap + 16); }
#pragma unroll
        for (int j = 0; j < 2; ++j) { const v4u v = *(const v4u*)(projb + (size_t)(tq0 + 2 * hh + j) * NPROJ + C_IW);
            C.wq[j][0] = bflo(v.x); C.wq[j][1] = bfhi(v.x); C.wq[j][2] = bflo(v.y); C.wq[j][3] = bfhi(v.y); C.wq[j][4] = bflo(v.z); C.wq[j][5] = bfhi(v.z); C.wq[j][6] = bflo(v.w); C.wq[j][7] = bfhi(v.w); }
        C.tqj0 = tq0 + 2 * hh; C.tqj1 = C.tqj0 + 1; C.hh = hh; C.kl = kl;
        C.rd0 = kl * 64 + ((hh ^ ((kl >> 2) & 3)) * 16); C.rd1 = kl * 64 + (((hh + 2) ^ ((kl >> 2) & 3)) * 16);
        C.hist = hist; C.sel = sel; C.cand_u = cand_u; C.cand_i = cand_i; C.shift = 24; C.himask = 0u;
        const int ntile = (t0 >> 5) + 1, nchunk = (ntile + 7) >> 3, nkeys = ntile * 32, sstride = ntile >> 3;
        { const v4u z = {0u, 0u, 0u, 0u};
#pragma unroll
          for (int i = 0; i < 8; ++i) *(LAS v4u*)(hist + 4 * (lane + 64 * i)) = z; }
        if (tid == 0) flag[0] = 0u;
        S.prefix0 = 0u; S.prefix1 = 0u; S.need0 = TOPK; S.need1 = TOPK; S.eqt0 = 0u; S.eqt1 = 0u; S.cnt0 = 0u; S.cnt1 = 0u; S.cc0 = 0u; S.cc1 = 0u;
        S.blo0 = 0u; S.blo1 = 0u; S.inv0 = 0.f; S.inv1 = 0.f; S.c00 = 0.f; S.c01 = 0.f;
        idx_sweep<6>(C, S, ikbuf, ikb, tid, ntile, nchunk, nkeys, sstride);
        bool fast;
        {
            float sum0 = 0.f, sum1 = 0.f, sq0 = 0.f, sq1 = 0.f;
#pragma unroll
            for (int r = 0; r < 8; ++r) { sum0 += S.ss0[r]; sq0 = fmaf(S.ss0[r], S.ss0[r], sq0); sum1 += S.ss1[r]; sq1 = fmaf(S.ss1[r], S.ss1[r], sq1); }
#pragma unroll
            for (int o = 1; o < 32; o <<= 1) { sum0 += __shfl_xor(sum0, o); sq0 += __shfl_xor(sq0, o); sum1 += __shfl_xor(sum1, o); sq1 += __shfl_xor(sq1, o); }
            const float m0 = sum0 * (1.f / 256.f), m1 = sum1 * (1.f / 256.f);
            const float sd0 = sqrtf(fmaxf(sq0 * (1.f / 256.f) - m0 * m0, 0.f)), sd1 = sqrtf(fmaxf(sq1 * (1.f / 256.f) - m1 * m1, 0.f));
            const bool ok = (sd0 > 1e-30f) && (sd0 < 1e30f) && (sd1 > 1e-30f) && (sd1 < 1e30f);
            S.inv0 = 512.f / (11.f * sd0); S.inv1 = 512.f / (11.f * sd1);
            S.c00 = -(m0 - 5.f * sd0) * S.inv0; S.c01 = -(m1 - 5.f * sd1) * S.inv1;
            unsigned sb0[8], sb1[8];
#pragma unroll
            for (int r = 0; r < 8; ++r) { sb0[r] = lin_bin(S.ss0[r], S.inv0, S.c00); sb1[r] = lin_bin(S.ss1[r], S.inv1, S.c01); }
            const float ks0 = 65536.f / (float)(C.tqj0 + 1), ks1 = 65536.f / (float)(C.tqj1 + 1);
            const float kf0 = ks0 + 5.f * sqrtf(ks0) + 4.f, kf1 = ks1 + 5.f * sqrtf(ks1) + 4.f;
            const unsigned klo0 = kf0 >= 255.f ? 257u : (unsigned)kf0 + 1u, klo1 = kf1 >= 255.f ? 257u : (unsigned)kf1 + 1u;
            unsigned lo0 = 0u, hi0 = 512u, lo1 = 0u, hi1 = 512u;
#pragma unroll 1
            for (int step = 0; step < 9; ++step) {
                const unsigned mid0 = (lo0 + hi0) >> 1, mid1 = (lo1 + hi1) >> 1;
                unsigned n0 = 0u, n1 = 0u;
#pragma unroll
                for (int r = 0; r < 8; ++r) { n0 += (sb0[r] >= mid0) ? 1u : 0u; n1 += (sb1[r] >= mid1) ? 1u : 0u; }
#pragma unroll
                for (int o = 1; o < 32; o <<= 1) { n0 += (unsigned)__shfl_xor((int)n0, o); n1 += (unsigned)__shfl_xor((int)n1, o); }
                if (n0 >= klo0) lo0 = mid0; else hi0 = mid0;
                if (n1 >= klo1) lo1 = mid1; else hi1 = mid1;
            }
            S.blo0 = lo0; S.blo1 = lo1;
            if (__any(!ok) && lane == 0) __hip_atomic_fetch_or(flag, 1u, __ATOMIC_RELAXED, __HIP_MEMORY_SCOPE_WORKGROUP);
            LDS_WAIT();
            __syncthreads();
            fast = (flag[0] == 0u);
        }
        if (fast) {
            idx_sweep<7>(C, S, ikbuf, ikb, tid, ntile, nchunk, nkeys, sstride);
            LDS_WAIT();
            bool good = true;
#pragma unroll
            for (int qq = 0; qq < 4; ++qq) {
                int bin; unsigned above, binc;
                hist_scan512(hist + qq * 512, (unsigned)TOPK, lane, bin, above, binc);
                const unsigned tot = above + binc;
                if (hh == (qq >> 1)) { if (qq & 1) { S.prefix1 = (unsigned)bin; S.need1 = TOPK - above; } else { S.prefix0 = (unsigned)bin; S.need0 = TOPK - above; } }
                good = good && (binc <= (unsigned)CAND_CAP) && (tot >= (unsigned)TOPK);
            }
            { const v4u z = {0u, 0u, 0u, 0u};
#pragma unroll
              for (int i = 0; i < 8; ++i) *(LAS v4u*)(hist + 4 * (lane + 64 * i)) = z; }
            if (!good && lane == 0) __hip_atomic_fetch_or(flag, 1u, __ATOMIC_RELAXED, __HIP_MEMORY_SCOPE_WORKGROUP);
            LDS_WAIT();
            __syncthreads();
            fast = (flag[0] == 0u);
        }
        if (fast) {
            idx_sweep<8>(C, S, ikbuf, ikb, tid, ntile, nchunk, nkeys, sstride);
            LDS_WAIT();
#pragma unroll
            for (int qq = 0; qq < 4; ++qq) {
                const int own = (qq >> 1) * 32;
                const unsigned Cn = (unsigned)__shfl((int)((qq & 1) ? S.cc1 : S.cc0), own), nd = (unsigned)__shfl((int)((qq & 1) ? S.need1 : S.need0), own), cq = (unsigned)__shfl((int)((qq & 1) ? S.cnt1 : S.cnt0), own);
                const unsigned Cc = Cn < (unsigned)CAND_CAP ? Cn : (unsigned)CAND_CAP;
                unsigned cqq = cq;
#pragma unroll 1
                for (unsigned base = 0; base < Cc; base += 64) {
                    const unsigned i = base + lane;
                    const unsigned ui = cand_u[qq * CAND_CAP + (i & (CAND_CAP - 1))]; const unsigned ii = cand_i[qq * CAND_CAP + (i & (CAND_CAP - 1))];
                    unsigned rank = 0u;
#pragma unroll 1
                    for (unsigned j = 0; j < Cc; ++j) { const unsigned uj = cand_u[qq * CAND_CAP + j], ij = cand_i[qq * CAND_CAP + j]; rank += ((uj > ui) || (uj == ui && ij < ii)) ? 1u : 0u; }
                    const bool take = (i < Cc) && (rank < nd);
                    const unsigned long long mt = __ballot(take);
                    const unsigned pos = cqq + __popcll(mt & ((1ull << lane) - 1ull));
                    if (take && pos < TOPK) sel[qq * 256 + pos] = (unsigned short)ii;
                    cqq += __popcll(mt);
                }
            }
        } else {
            S.prefix0 = 0u; S.prefix1 = 0u; S.need0 = TOPK; S.need1 = TOPK; S.cnt0 = 0u; S.cnt1 = 0u; S.eqt0 = 0u; S.eqt1 = 0u;
#pragma unroll 1
            for (int pass = 0; pass < 4; ++pass) {
                C.shift = 24 - 8 * pass; C.himask = pass ? (0xFFFFFFFFu << (32 - 8 * pass)) : 0u;
                idx_sweep<0>(C, S, ikbuf, ikb, tid, ntile, nchunk, nkeys, sstride);
                LDS_WAIT();
#pragma unroll
                for (int qq = 0; qq < 4; ++qq) {
                    const unsigned nd = (unsigned)__shfl((int)((qq & 1) ? S.need1 : S.need0), (qq >> 1) * 32);
                    int bin; unsigned above, binc;
                    hist_scan(hist + qq * 256, nd, lane, bin, above, binc);
                    if (hh == (qq >> 1)) { if (qq & 1) { S.prefix1 |= (unsigned)bin << C.shift; S.need1 -= above; } else { S.prefix0 |= (unsigned)bin << C.shift; S.need0 -= above; } }
                    const v4u z = {0u, 0u, 0u, 0u}; *(LAS v4u*)(hist + qq * 256 + 4 * lane) = z;
                }
                LDS_WAIT();
            }
            idx_sweep<4>(C, S, ikbuf, ikb, tid, ntile, nchunk, nkeys, sstride);
        }
        LDS_WAIT();
    } else {
#pragma unroll
        for (int qq = 0; qq < 4; ++qq)
#pragma unroll
            for (int i = 0; i < 4; ++i) sel[qq * 256 + lane + 64 * i] = (unsigned short)(lane + 64 * i);
        LDS_WAIT();
    }

    const int n16 = lane & 15, g = lane >> 4;
    for (int repa = 0; repa < 1 + REP_ATT; ++repa)
#pragma unroll 1
    for (int qq = 0; qq < 4; ++qq) {
        const int tq = tq0 + qq; const int nsel = (tq + 1) < TOPK ? (tq + 1) : TOPK;
        bf16x8 Bq[4];
#pragma unroll
        for (int ks = 0; ks < 4; ++ks) {
            bf16x8 z = {0, 0, 0, 0, 0, 0, 0, 0};
            if (n16 < 8) z = *(const bf16x8*)(projb + (size_t)tq * NPROJ + C_QL + n16 * 128 + 32 * ks + 8 * g);
            Bq[ks] = z;
        }
        float m_run = -INFINITY, lsum = 0.f;
        f32x4 O[8];
#pragma unroll
        for (int ct = 0; ct < 8; ++ct) O[ct] = (f32x4){0.f, 0.f, 0.f, 0.f};
        const int nch = (nsel + 31) >> 5;
        v4u gv[8]; f32x4 pq = {0.f, 0.f, 0.f, 0.f};
#pragma unroll
        for (int it = 0; it < 8; ++it) { const int si = g + 4 * it; const int ki = (si < nsel) ? (int)sel[qq * 256 + si] : 0; gv[it] = *(const v4u*)(ckvb + (size_t)ki * 128 + n16 * 8); }
        if (lane < 32) { const int ki = (lane < nsel) ? (int)sel[qq * 256 + lane] : 0; pq = *(const f32x4*)(ssqb + (size_t)ki * 4); }
#pragma unroll 1
        for (int c = 0; c < nch; ++c) {
#pragma unroll
            for (int it = 0; it < 8; ++it) { const int i = g + 4 * it; *(LAS v4u*)(cbuf + 256 * i + 16 * (n16 ^ swz16(i))) = gv[it]; }
            if (lane < 32) rsbuf[lane] = 1.0f / sqrtf(((pq[0] + pq[1]) + (pq[2] + pq[3])) * (1.f / 128.f) + LN_EPS);
            LDS_WAIT();
            if (c + 1 < nch) {
#pragma unroll
                for (int it = 0; it < 8; ++it) { const int si = 32 * (c + 1) + g + 4 * it; const int ki = (si < nsel) ? (int)sel[qq * 256 + si] : 0; gv[it] = *(const v4u*)(ckvb + (size_t)ki * 128 + n16 * 8); }
                if (lane < 32) { const int si = 32 * (c + 1) + lane; const int ki = (si < nsel) ? (int)sel[qq * 256 + si] : 0; pq = *(const f32x4*)(ssqb + (size_t)ki * 4); }
            }
            f32x4 sc[2];
#pragma unroll
            for (int tt = 0; tt < 2; ++tt) {
                f32x4 a = {0.f, 0.f, 0.f, 0.f};
                const int row = 16 * tt + n16;
#pragma unroll
                for (int ks = 0; ks < 4; ++ks) {
                    const bf16x8 af = *(LAS bf16x8*)(cbuf + 256 * row + 16 * ((4 * ks + g) ^ swz16(row)));
                    a = __builtin_amdgcn_mfma_f32_16x16x32_bf16(af, Bq[ks], a, 0, 0, 0);
                }
                sc[tt] = a;
            }
            f32x4 rsv[2];
            rsv[0] = *(LAS f32x4*)(rsbuf + 4 * g); rsv[1] = *(LAS f32x4*)(rsbuf + 16 + 4 * g);
            float cmax = -INFINITY;
#pragma unroll
            for (int tt = 0; tt < 2; ++tt)
#pragma unroll
                for (int r = 0; r < 4; ++r) { float s = sc[tt][r] * rsv[tt][r]; if (32 * c + 16 * tt + 4 * g + r >= nsel) s = -INFINITY; sc[tt][r] = s; cmax = fmaxf(cmax, s); }
            cmax = fmaxf(cmax, __shfl_xor(cmax, 16)); cmax = fmaxf(cmax, __shfl_xor(cmax, 32));
            const float mnew = fmaxf(m_run, cmax);
            const float alpha = __expf(m_run - mnew);
            float psum = 0.f; float pp[2][4];
#pragma unroll
            for (int tt = 0; tt < 2; ++tt)
#pragma unroll
                for (int r = 0; r < 4; ++r) { const float p = __expf(sc[tt][r] - mnew); psum += p; pp[tt][r] = p * rsv[tt][r]; }
            lsum = lsum * alpha + psum; m_run = mnew;
            bf16x8 PA;
            { v4u pw; pw.x = pk2(pp[0][0], pp[0][1]); pw.y = pk2(pp[0][2], pp[0][3]); pw.z = pk2(pp[1][0], pp[1][1]); pw.w = pk2(pp[1][2], pp[1][3]); PA = __builtin_bit_cast(bf16x8, pw); }
            float ar[4];
#pragma unroll
            for (int r = 0; r < 4; ++r) ar[r] = __shfl(alpha, 4 * g + r);
#pragma unroll
            for (int ct = 0; ct < 8; ++ct) { O[ct][0] *= ar[0]; O[ct][1] *= ar[1]; O[ct][2] *= ar[2]; O[ct][3] *= ar[3]; }
            { const int qrow = (n16 >> 2), p4 = n16 & 3;
              const int rlo = 4 * g + qrow, rhi = 16 + 4 * g + qrow;
#pragma unroll
              for (int ct = 0; ct < 8; ++ct) {
                  const int ch = 2 * ct + (p4 >> 1);
                  const s16x4 lo = __builtin_bit_cast(s16x4, __builtin_amdgcn_ds_read_tr16_b64_v4i16((LAS s16x4*)(cbuf + 256 * rlo + 16 * (ch ^ swz16(rlo)) + 8 * (p4 & 1))));
                  const s16x4 hi = __builtin_bit_cast(s16x4, __builtin_amdgcn_ds_read_tr16_b64_v4i16((LAS s16x4*)(cbuf + 256 * rhi + 16 * (ch ^ swz16(rhi)) + 8 * (p4 & 1))));
                  const bf16x8 vf = {lo[0], lo[1], lo[2], lo[3], hi[0], hi[1], hi[2], hi[3]};
                  O[ct] = __builtin_amdgcn_mfma_f32_16x16x32_bf16(PA, vf, O[ct], 0, 0, 0);
              } }
            LDS_WAIT();
            asm volatile("" ::: "memory");
        }
        float ltot = lsum; ltot += __shfl_xor(ltot, 16); ltot += __shfl_xor(ltot, 32);
        const float inv = 1.0f / ltot;
        float ir[4];
#pragma unroll
        for (int r = 0; r < 4; ++r) ir[r] = __shfl(inv, 4 * g + r);
        if (g < 2) {
#pragma unroll
            for (int ct = 0; ct < 8; ++ct)
#pragma unroll
                for (int r = 0; r < 4; ++r) obuf[(4 * g + r) * 128 + 16 * ct + n16] = (bf16_t)f2bf(O[ct][r] * ir[r]);
        }
        LDS_WAIT();
        { bf16_t* dst = P.ymix + (size_t)(b * SEQ + tq) * KMIX;
#pragma unroll
          for (int k = 0; k < 2; ++k) { const int piece = lane + 64 * k; *(v4u*)(dst + piece * 8) = *(LAS v4u*)((LAS unsigned char*)obuf + piece * 16); } }
        LDS_WAIT();
        asm volatile("" ::: "memory");
    }
    __syncthreads();
}

#ifndef REP_CP
#define REP_CP 0
#endif
#ifndef REP_DSA
#define REP_DSA 0
#endif
__device__ __forceinline__ void phase_mixers(const Frame& F0, int l) {
    const Frame F = relaunder(F0);
    KArgs A = kargs();
    MixP P;
    P.proj = ws_bf(A, WS_PROJ); P.ikc = ws_bf(A, WS_IKC); P.ckvc = ws_bf(A, WS_CKVC); P.ymix = ws_bf(A, WS_YMIX); P.ssq = (const float*)(A->ws + WS_SSQ);
    P.w_pool = A->in[5] + (size_t)l * 4 * 64 * 64; P.pool_scale = A->in[6] + l * 256; P.conv_w = A->in[7] + (size_t)l * 31 * 256; P.conv_b = A->in[8] + l * 256;
    P.cln_g = A->in[9] + l * 256; P.cln_b = A->in[10] + l * 256;
#ifndef NO_CONVPOOL
#pragma unroll 1
    for (int rep = 0; rep < 1 + REP_CP; ++rep)
#pragma unroll 1
    for (int tile = F.bid; tile < M / 32; tile += F.G) conv_pool_tile(F, P, tile);
#endif
    __syncthreads();
#pragma unroll 1
    for (int rep = 0; rep < 1 + REP_DSA; ++rep)
#pragma unroll 1
    for (int it = F.bid; it < 512; it += F.G) {
        const int b = it >> 8, gi = it & 255; const int grp = b ? (255 - gi) : gi;
#ifndef NO_DSA
        dsa_group(F, P, b, grp * 32);
#endif
    }
    __syncthreads();
}

__device__ __forceinline__ float top2sum4(float a, float b, float c, float d) {
    const float hi1 = fmaxf(a, b), lo1 = fminf(a, b), hi2 = fmaxf(c, d), lo2 = fminf(c, d);
    const float top = fmaxf(hi1, hi2), second = fmaxf(fminf(hi1, hi2), (hi1 >= hi2) ? lo1 : lo2);
    return top + second;
}
__device__ __forceinline__ void phase_ln1_router(const Frame& F0, int l) {
    const Frame F = relaunder(F0);
    KArgs A = kargs();
    float* out = A->out; bf16_t* xb = ws_bf(A, WS_XB);
    const float* ln1_g = A->in[12] + l * DM; const float* ln1_b = A->in[13] + l * DM; const float* router_w = A->in[14]; const float* router_b = A->in[15];
    int* toke = (int*)(A->ws + WS_TOKE); float* tokg = (float*)(A->ws + WS_TOKG); unsigned* blkcnt = (unsigned*)(A->ws + WS_BLKCNT);
    const int lane = F.lane, wave = F.wave;
    LAS float* xs = (LAS float*)(F.lds + wave * 4096);
    LAS unsigned* cnt = (LAS unsigned*)(F.lds + LDS_MISC + 512);
    if (F.tid < 16) cnt[F.tid] = 0u;
    __syncthreads();
    const int e16 = lane & 15, qr = lane >> 4;
    const float bias_e = router_b[e16];
#pragma unroll 1
    for (int i = 0; i < 8; ++i) {
        const int row = F.bid * 64 + wave * 8 + i;
        float* vr = out + (size_t)row * DM;
        f32x4 v[4]; float s = 0.f;
#pragma unroll
        for (int j = 0; j < 4; ++j) { v[j] = *(const f32x4*)(vr + 4 * lane + 256 * j); s += (v[j][0] + v[j][1]) + (v[j][2] + v[j][3]); }
        const float mean = wave_sum(s) * (1.f / DM); float s2 = 0.f;
#pragma unroll
        for (int j = 0; j < 4; ++j) { v[j] = v[j] - mean; s2 += (v[j][0] * v[j][0] + v[j][1] * v[j][1]) + (v[j][2] * v[j][2] + v[j][3] * v[j][3]); }
        const float rstd = 1.0f / sqrtf(wave_sum(s2) * (1.f / DM) + LN_EPS);
#pragma unroll
        for (int j = 0; j < 4; ++j) {
            const f32x4 g = *(const f32x4*)(ln1_g + 4 * lane + 256 * j), b = *(const f32x4*)(ln1_b + 4 * lane + 256 * j);
            const f32x4 y = v[j] * rstd * g + b;
            *(f32x4*)(vr + 4 * lane + 256 * j) = y;
            v2u w; w.x = pk2(y[0], y[1]); w.y = pk2(y[2], y[3]); *(v2u*)(xb + (size_t)row * DM + 4 * lane + 256 * j) = w;
            *(LAS f32x4*)(xs + 4 * lane + 256 * j) = y;
        }
        LDS_WAIT();
        float acc = 0.f;
        { const float* rw = router_w + (size_t)(qr * 256) * NE + e16; const LAS float* xq = xs + qr * 256;
#pragma unroll 8
          for (int c = 0; c < 256; ++c) acc += xq[c] * rw[c * NE]; }
        acc += __shfl_xor(acc, 16); acc += __shfl_xor(acc, 32);
        const float aff = sigmoidf_(acc), scv = aff + bias_e;
        float sv[16];
#pragma unroll
        for (int k = 0; k < 16; ++k) sv[k] = __shfl(scv, k);
        float gs[4];
#pragma unroll
        for (int gq = 0; gq < 4; ++gq) gs[gq] = top2sum4(sv[4 * gq], sv[4 * gq + 1], sv[4 * gq + 2], sv[4 * gq + 3]);
        int best = 0; float bv = gs[0];
#pragma unroll
        for (int gq = 1; gq < 4; ++gq) if (gs[gq] > bv) { bv = gs[gq]; best = gq; }
        float c0 = sv[0], c1 = sv[1], c2 = sv[2], c3 = sv[3];
#pragma unroll
        for (int gq = 1; gq < 4; ++gq) if (best == gq) { c0 = sv[4 * gq]; c1 = sv[4 * gq + 1]; c2 = sv[4 * gq + 2]; c3 = sv[4 * gq + 3]; }
        int i1 = 0; float m1 = c0;
        if (c1 > m1) { m1 = c1; i1 = 1; } if (c2 > m1) { m1 = c2; i1 = 2; } if (c3 > m1) { m1 = c3; i1 = 3; }
        int i2 = -1; float m2 = -INFINITY;
        if (i1 != 0 && c0 > m2) { m2 = c0; i2 = 0; } if (i1 != 1 && c1 > m2) { m2 = c1; i2 = 1; } if (i1 != 2 && c2 > m2) { m2 = c2; i2 = 2; } if (i1 != 3 && c3 > m2) { m2 = c3; i2 = 3; }
        if (i2 < 0) i2 = (i1 == 0) ? 1 : 0;
        const int e1 = 4 * best + i1, e2 = 4 * best + i2;
        const float a1 = __shfl(aff, e1), a2 = __shfl(aff, e2);
        const float den = a1 + a2;
        if (lane == 0) {
            toke[row * 2] = e1; toke[row * 2 + 1] = e2; tokg[row * 2] = a1 / den; tokg[row * 2 + 1] = a2 / den;
            __hip_atomic_fetch_add(cnt + e1, 1u, __ATOMIC_RELAXED, __HIP_MEMORY_SCOPE_WORKGROUP);
            __hip_atomic_fetch_add(cnt + e2, 1u, __ATOMIC_RELAXED, __HIP_MEMORY_SCOPE_WORKGROUP);
        }
        LDS_WAIT();
    }
    __syncthreads();
    if (F.tid < 16) blkcnt[F.bid * 16 + F.tid] = cnt[F.tid];
}

__device__ __forceinline__ void phase_route(const Frame& F0) {
    const Frame F = relaunder(F0);
    KArgs A = kargs();
    const bf16_t* xb = ws_bf(A, WS_XB); bf16_t* xs = ws_bf(A, WS_XS);
    const int* toke = (const int*)(A->ws + WS_TOKE); const float* tokg = (const float*)(A->ws + WS_TOKG); int* toks = (int*)(A->ws + WS_TOKS);
    float* gslot = (float*)(A->ws + WS_GSLOT); int* tiletab = (int*)(A->ws + WS_TILETAB); const unsigned* blkcnt = (const unsigned*)(A->ws + WS_BLKCNT);
    const int lane = F.lane, wave = F.wave;
    LAS int* slots = (LAS int*)(F.lds + LDS_MISC + 1024);
    if (wave == 0) {
        const int e = lane & 15, part = lane >> 4;
        unsigned tot = 0u, pre = 0u;
        for (int bb = part; bb < F.G; bb += 4) { const unsigned c = (unsigned)ld_agent((const int*)blkcnt + bb * 16 + e); tot += c; if (bb < F.bid) pre += c; }
        tot += __shfl_xor((int)tot, 16); tot += __shfl_xor((int)tot, 32);
        pre += __shfl_xor((int)pre, 16); pre += __shfl_xor((int)pre, 32);
        const unsigned padded = (tot + 255u) & ~255u;
        unsigned off = 0u, total_pad = 0u;
#pragma unroll
        for (int k = 0; k < 16; ++k) { const unsigned pk = (unsigned)__shfl((int)padded, k); if (k < e) off += pk; total_pad += pk; }
        unsigned base = off + pre;
        const int myrow = F.bid * 64 + lane;
        const int me1 = ld_agent(toke + myrow * 2), me2 = ld_agent(toke + myrow * 2 + 1);
        const float mg1 = ld_agent_f(tokg + myrow * 2), mg2 = ld_agent_f(tokg + myrow * 2 + 1);
        unsigned ms1 = 0u, ms2 = 0u;
#pragma unroll 1
        for (int i = 0; i < 64; ++i) {
            const int e1 = __shfl(me1, i), e2 = __shfl(me2, i);
            const unsigned s1 = (unsigned)__shfl((int)base, e1); base += (e == e1) ? 1u : 0u;
            const unsigned s2 = (unsigned)__shfl((int)base, e2); base += (e == e2) ? 1u : 0u;
            if (lane == i) { ms1 = s1; ms2 = s2; }
        }
        slots[2 * lane] = (int)ms1; slots[2 * lane + 1] = (int)ms2; toks[myrow * 2] = (int)ms1; toks[myrow * 2 + 1] = (int)ms2;
        gslot[ms1] = mg1; gslot[ms2] = mg2;
        if (F.bid == 0) {
            const int ntile = (int)(total_pad >> 8);
            if (lane == 0) tiletab[0] = ntile;
            for (int t = lane; t < ntile; t += 64) {
                int ex = 0;
#pragma unroll
                for (int k = 0; k < 16; ++k) { const unsigned ok = (unsigned)__shfl((int)off, k); if ((unsigned)(t * 256) >= ok) ex = k; }
                tiletab[1 + t] = ex;
            }
#pragma unroll
            for (int k = 0; k < 16; ++k) {
                const unsigned ok = (unsigned)__shfl((int)off, k), tk = (unsigned)__shfl((int)tot, k), pk = (unsigned)__shfl((int)padded, k);
                for (unsigned s = ok + tk + lane; s < ok + pk; s += 64) gslot[s] = 0.f;
            }
        }
    }
    LDS_WAIT();
    __syncthreads();
#pragma unroll 1
    for (int i = 0; i < 8; ++i) {
        const int ti = wave * 8 + i, row = F.bid * 64 + ti;
        const v4u a = *(const v4u*)(xb + (size_t)row * DM + lane * 8), b = *(const v4u*)(xb + (size_t)row * DM + 512 + lane * 8);
#pragma unroll
        for (int k = 0; k < 2; ++k) { const int s = slots[2 * ti + k]; bf16_t* d = xs + (size_t)s * DM; *(v4u*)(d + lane * 8) = a; *(v4u*)(d + 512 + lane * 8) = b; }
    }
}

__device__ __forceinline__ void phase_ln2(const Frame& F0, int l) {
    const Frame F = relaunder(F0);
    KArgs A = kargs();
    float* out = A->out; bf16_t* xb = ws_bf(A, WS_XB); const int* toks = (const int*)(A->ws + WS_TOKS);
    const float* ln2_g = A->in[19] + l * DM; const float* ln2_b = A->in[20] + l * DM;
    const int lane = F.lane, wave = F.wave;
    const bf16_t* Y = ws_bf(A, WS_XS);
#pragma unroll 1
    for (int i = 0; i < 8; ++i) {
        const int row = F.bid * 64 + wave * 8 + i;
        const int s0 = ld_agent(toks + row * 2), s1 = ld_agent(toks + row * 2 + 1);
        float* vr = out + (size_t)row * DM;
        f32x4 v[4]; float s = 0.f;
#pragma unroll
        for (int j = 0; j < 4; ++j) {
            const f32x4 x = *(const f32x4*)(vr + 4 * lane + 256 * j);
            const v2u y0 = *(const v2u*)(Y + (size_t)s0 * DM + 4 * lane + 256 * j), y1 = *(const v2u*)(Y + (size_t)s1 * DM + 4 * lane + 256 * j);
            f32x4 f; f[0] = bflo(y0.x) + bflo(y1.x); f[1] = bfhi(y0.x) + bfhi(y1.x); f[2] = bflo(y0.y) + bflo(y1.y); f[3] = bfhi(y0.y) + bfhi(y1.y);
            v[j] = x * ALPHA + f; s += (v[j][0] + v[j][1]) + (v[j][2] + v[j][3]);
        }
        const float mean = wave_sum(s) * (1.f / DM); float s2 = 0.f;
#pragma unroll
        for (int j = 0; j < 4; ++j) { v[j] = v[j] - mean; s2 += (v[j][0] * v[j][0] + v[j][1] * v[j][1]) + (v[j][2] * v[j][2] + v[j][3] * v[j][3]); }
        const float rstd = 1.0f / sqrtf(wave_sum(s2) * (1.f / DM) + LN_EPS);
#pragma unroll
        for (int j = 0; j < 4; ++j) {
            const f32x4 g = *(const f32x4*)(ln2_g + 4 * lane + 256 * j), b = *(const f32x4*)(ln2_b + 4 * lane + 256 * j);
            const f32x4 y = v[j] * rstd * g + b;
            *(f32x4*)(vr + 4 * lane + 256 * j) = y;
            v2u w; w.x = pk2(y[0], y[1]); w.y = pk2(y[2], y[3]); *(v2u*)(xb + (size_t)row * DM + 4 * lane + 256 * j) = w;
        }
    }
}

constexpr int N_PHASES = 17;

__global__ void __launch_bounds__(NTHR, 2) fwd_kernel(Args args) {
    extern __shared__ __attribute__((aligned(16))) unsigned char lds_raw[];
    cg::grid_group grid = cg::this_grid();
    Frame F;
    F.lds = (LAS unsigned char*)lds_raw;
    F.tid = threadIdx.x; F.lane = F.tid & 63; F.wave = __builtin_amdgcn_readfirstlane(F.tid >> 6);
    F.G = gridDim.x; F.bid = blockIdx.x;
    const int lo = args.ph_lo, hi = args.ph_hi, coop = args.coop;
    if (F.tid < 32) ((LAS unsigned*)(F.lds + LDS_MISC))[F.tid] = 0u;
    __syncthreads();
    XcdBarrier bar; bar.bar = nullptr; bar.x = 0; bar.st = nullptr;
    if (coop) bar = xcd_barrier_post((unsigned*)(kargs()->ws + WS_BAR), (volatile LAS unsigned*)(F.lds + LDS_MISC) + 8);
#ifndef PHMASK
#define PHMASK 0x1ff
#endif
#define IN(k) (lo <= (k) && (k) < hi)
#define EN(b) ((PHMASK >> (b)) & 1)
#ifndef REPMASK
#define REPMASK 0
#endif
#define NREP(b) (1 + ((REPMASK >> (b)) & 1))
#define SEAM(k) do { if (IN(k) && IN((k) + 1)) { if (coop) { if ((k) == 0) grid.sync(); else xcd_barrier(bar); } } } while (0)

    if (EN(0) && IN(0)) for (int rep = 0; rep < NREP(0); ++rep) { if (rep) xcd_barrier(bar); phase_convert(F, 0, true); }
    SEAM(0);
#pragma unroll 1
    for (int l = 0; l < 2; ++l) {
        const int pb = 1 + 8 * l;
        if (EN(1) && IN(pb + 0)) for (int rep = 0; rep < NREP(1); ++rep) {
            if (rep) xcd_barrier(bar);
            KArgs A = kargs();
            pg8::Gemm g{ws_bf(A, WS_XB), ws_bf(A, WS_WIN), M, NPROJ, DM}; pg8::StaticOrder S; S.init(M, NPROJ, F.G, F.bid);
            EpiProj E{ws_bf(A, WS_PROJ), (float*)(A->ws + WS_SSQ), ws_bf(A, WS_IKC), ws_bf(A, WS_CKVC)};
            pg8::gemm_phase<EpiProj, pg8::StaticOrder, true, true>(F.lds, g, S, E);
        }
        SEAM(pb + 0);
        if (EN(2) && IN(pb + 1)) for (int rep = 0; rep < NREP(2); ++rep) { if (rep) xcd_barrier(bar); phase_mixers(F, l); }
        SEAM(pb + 1);
        if (EN(3) && IN(pb + 2)) {
            KArgs A = kargs();
            pg8::Gemm g{ws_bf(A, WS_YMIX), ws_bf(A, WS_WO), M, DM, KMIX}; pg8::StaticOrder S; S.init(M, DM, F.G, F.bid);
            EpiMix E{l == 0 ? A->in[0] : (const float*)A->out, A->out};
            pg8::gemm_phase<EpiMix, pg8::StaticOrder, true, true>(F.lds, g, S, E);
        }
        SEAM(pb + 2);
        if (EN(4) && IN(pb + 3)) phase_ln1_router(F, l);
        SEAM(pb + 3);
        if (EN(5) && IN(pb + 4)) for (int rep = 0; rep < NREP(5); ++rep) { if (rep) xcd_barrier(bar); phase_route(F); }
        SEAM(pb + 4);
        if (EN(6) && IN(pb + 5)) for (int rep = 0; rep < NREP(6); ++rep) {
            if (rep) xcd_barrier(bar);
            KArgs A = kargs();
            pg8::Gemm g{ws_bf(A, WS_XS), ws_bf(A, WS_WGU), MAXSLOT, NE * 1024, DM}; GroupedOrder S; S.init((const int*)(A->ws + WS_TILETAB), F.G, F.bid);
            EpiGU E{ws_bf(A, WS_H), (const float*)(A->ws + WS_GSLOT)};
            pg8::gemm_phase<EpiGU, GroupedOrder, true, true>(F.lds, g, S, E);
        }
        SEAM(pb + 5);
        if (EN(7) && IN(pb + 6)) for (int rep = 0; rep < NREP(7); ++rep) {
            if (rep) xcd_barrier(bar);
            KArgs A = kargs();
            pg8::Gemm g{ws_bf(A, WS_H), ws_bf(A, WS_WD), MAXSLOT, NE * 1024, DE}; GroupedOrder S; S.init((const int*)(A->ws + WS_TILETAB), F.G, F.bid);
            EpiDown E{ws_bf(A, WS_XS)};
            pg8::gemm_phase<EpiDown, GroupedOrder, true, true>(F.lds, g, S, E);
        }
        SEAM(pb + 6);
        if (EN(8) && IN(pb + 7)) {
            phase_ln2(F, l);
            if (l == 0) { __syncthreads(); phase_convert(F, 1, false); }
        }
        if (l == 0) SEAM(pb + 7);
    }
#undef IN
#undef SEAM
}

#ifndef MK_N_LAUNCHES
#define MK_N_LAUNCHES 1
#endif

extern "C" void kernel_launch(void* const* d_in, const int* in_sizes, int n_in, void* d_out, int out_size, void* d_ws, size_t ws_size, hipStream_t stream) {
    static int grid = 0;
    if (grid == 0) {
        int dev = 0, cus = 0, per_cu = 0;
        if (n_in != 21 || out_size != M * DM || ws_size < WS_END) { fprintf(stderr, "kernel_launch: unexpected problem (n_in %d out %d ws %zu)\n", n_in, out_size, ws_size); grid = -1; return; }
        if (hipGetDevice(&dev) != hipSuccess || hipDeviceGetAttribute(&cus, hipDeviceAttributeMultiprocessorCount, dev) != hipSuccess) { grid = -1; return; }
        if (hipFuncSetAttribute((const void*)fwd_kernel, hipFuncAttributeMaxDynamicSharedMemorySize, LDS_BYTES) != hipSuccess) { fprintf(stderr, "kernel_launch: hipFuncSetAttribute failed\n"); grid = -1; return; }
        if (hipOccupancyMaxActiveBlocksPerMultiprocessor(&per_cu, (const void*)fwd_kernel, NTHR, LDS_BYTES) != hipSuccess || per_cu < 1) { fprintf(stderr, "kernel_launch: occupancy query says %d\n", per_cu); grid = -1; (void)hipGetLastError(); return; }
        grid = cus;
        if (grid != 256) { fprintf(stderr, "kernel_launch: built for 256 CUs, found %d\n", cus); grid = -1; return; }
    }
    if (grid < 0) return;
    if (hipMemsetAsync((char*)d_ws + WS_BAR, 0, 16384, stream) != hipSuccess) { fprintf(stderr, "kernel_launch: memset failed\n"); return; }
    Args a{};
    for (int i = 0; i < 21; ++i) a.in[i] = (const float*)d_in[i];
    a.out = (float*)d_out; a.ws = (unsigned char*)d_ws; a.pad = 0;
#if MK_N_LAUNCHES == 1
    a.ph_lo = 0; a.ph_hi = N_PHASES; a.coop = 1;
    void* kargs[] = {&a};
    hipError_t e = hipLaunchCooperativeKernel((const void*)fwd_kernel, dim3(grid), dim3(NTHR), kargs, LDS_BYTES, stream);
    if (e != hipSuccess) fprintf(stderr, "kernel_launch: cooperative launch failed: %s\n", hipGetErrorString(e));
#else
    for (int p = 0; p < N_PHASES; ++p) {
        a.ph_lo = p; a.ph_hi = p + 1; a.coop = 0;
        hipLaunchKernelGGL(fwd_kernel, dim3(grid), dim3(NTHR), LDS_BYTES, stream, a);
    }
#endif
}
```

```cpp
#include <hip/hip_runtime.h>
#include <hip/hip_cooperative_groups.h>
#include <cstdio>
#include <cstdint>
namespace cg = cooperative_groups;
namespace pg8 {
#define PG8_LAS __attribute__((address_space(3)))
typedef unsigned short bf16_t;
typedef short bf16x8 __attribute__((ext_vector_type(8)));
typedef float f32x4 __attribute__((ext_vector_type(4)));
typedef unsigned u32x4 __attribute__((ext_vector_type(4)));
constexpr int BM = 256, BK = 64, HALF = 128, HTB = HALF * BK * 2  , STAGE_BYTES = 8 * HTB, NXCD = 8, WGM = 8;

__host__ __device__ __forceinline__ int lds_byte(int r, int c) { const int st = (r >> 4) * 2 + (c >> 5), rr = r & 15, cc = c & 31, ob = rr * 64 + cc * 2; return st * 1024 + (ob ^ (((ob >> 9) & 1) << 5)); }
__host__ __device__ __forceinline__ void stage_rc(int b, int& R, int& C) { const int st = b / 1024, sb = b % 1024, swz = sb ^ (((sb >> 9) & 1) << 5); R = (st >> 1) * 16 + swz / 64; C = (st & 1) * 32 + (swz % 64) / 2; }
__host__ __device__ __forceinline__ int perm32(int rho) { const int n = rho >> 4, i = rho & 15; return 8 * (i >> 2) + 4 * n + (i & 3); }

struct Unit { int pm, pn; };
struct Gemm { const bf16_t* A; const bf16_t* Bt; int M, N, K; };

struct StaticOrder {
    int nM, nN, nwg, G, c;
    __host__ __device__ void init(int M, int N, int G_, int c_) { nM = M / BM; nN = N / BM; nwg = nM * nN; G = G_; c = c_; }
    __host__ __device__ bool next(int i, Unit& u) const {
        const long L = (long)i * G + c; if (L >= nwg) return false;
        int wgid = (int)L; { const int q = nwg / NXCD, r = nwg % NXCD, xcd = wgid % NXCD, off = wgid / NXCD; wgid = (xcd < r ? xcd * (q + 1) : r * (q + 1) + (xcd - r) * q) + off; }
        const int nig = WGM * nN, gid = wgid / nig, fm = gid * WGM, gsz = (nM - fm) < WGM ? (nM - fm) : WGM;
        u.pm = fm + ((wgid % nig) % gsz); u.pn = (wgid % nig) / gsz; return true;
    }
    __device__ __forceinline__ void a_ready(const Unit&) const {}
    __device__ __forceinline__ void done(const Unit&) const {}
};

template <class Epi, class Sched, bool ALIGN_EPI = false, bool SP2 = false>
__device__ __forceinline__ void gemm_phase(PG8_LAS unsigned char* lds, const Gemm g, const Sched& S, const Epi& E) {
    int tid_ = threadIdx.x; asm volatile("" : "+v"(tid_));
    const int tid = tid_, wid = __builtin_amdgcn_readfirstlane(tid >> 6), lane = tid & 63, wr = wid >> 2, wc = wid & 3, fr = lane & 15, fq = lane >> 4;
    const int K = g.K, nt = K / BK;
    unsigned voffA[2], voffB[2];
#pragma unroll
    for (int i = 0; i < 2; ++i) { int R, C; stage_rc(tid * 16 + i * 8192, R, C); const int Rb = Epi::PERM ? ((R & ~31) + perm32(R & 31)) : R;
        voffA[i] = (unsigned)(R * K + C) * 2u; voffB[i] = (unsigned)(Rb * K + C) * 2u; }
    const size_t kstep = (size_t)(BK * 2);
    const size_t hstep = (size_t)HALF * K * 2;
    const size_t tstep = 2 * hstep;
    const unsigned ldsw = (unsigned)wid * 1024u;
    const int aoff = lds_byte(wr * 64 + fr, fq * 8), boff = lds_byte(wc * 32 + fr, fq * 8);
#define PG8_SA(b, h) (((b) * 2 + (h)) * HTB)
#define PG8_SB(b, h) ((4 + (b) * 2 + (h)) * HTB)
#define PG8_STAGE(bufoff, gbase, voff) do { _Pragma("unroll") for (int _i = 0; _i < 2; ++_i) \
        __builtin_amdgcn_global_load_lds((const unsigned*)((const char*)(gbase) + (voff)[_i]), (PG8_LAS unsigned*)(lds + (bufoff) + ldsw + _i * 8192), 16, 0, 0); } while (0)
#define PG8_LDA(dst, b, h) do { _Pragma("unroll") for (int m = 0; m < 4; ++m) _Pragma("unroll") for (int k = 0; k < 2; ++k) dst[m][k] = *(const PG8_LAS bf16x8*)(lds + PG8_SA(b, h) + aoff + m * 2048 + k * 1024); } while (0)
#define PG8_LDB(dst, b, h) do { _Pragma("unroll") for (int n = 0; n < 2; ++n) _Pragma("unroll") for (int k = 0; k < 2; ++k) dst[n][k] = *(const PG8_LAS bf16x8*)(lds + PG8_SB(b, h) + boff + n * 2048 + k * 1024); } while (0)
#define PG8_MMA(ai, bj, At, Bt) do { __builtin_amdgcn_s_setprio(1); _Pragma("unroll") for (int m = 0; m < 4; ++m) _Pragma("unroll") for (int n = 0; n < 2; ++n) _Pragma("unroll") for (int k = 0; k < 2; ++k) \
        acc[ai][bj][m][n] = __builtin_amdgcn_mfma_f32_16x16x32_bf16(Bt[n][k], At[m][k], acc[ai][bj][m][n], 0, 0, 0); __builtin_amdgcn_s_setprio(0); } while (0)
#define PG8_WAIT_V(n) asm volatile("s_waitcnt vmcnt(" #n ")" ::: "memory")
#define PG8_WAIT_L(n) asm volatile("s_waitcnt lgkmcnt(" #n ")" ::: "memory")
#define PG8_BAR __builtin_amdgcn_s_barrier()
#define PG8_SCHED __builtin_amdgcn_sched_barrier(0)
    Unit cur, nxt; int ui = 0;
    if (!S.next(0, cur)) return;
    f32x4 acc[2][2][4][2];
#pragma unroll
    for (int a = 0; a < 2; ++a)
#pragma unroll
        for (int b = 0; b < 2; ++b)
#pragma unroll
            for (int m = 0; m < 4; ++m)
#pragma unroll
                for (int n = 0; n < 2; ++n) acc[a][b][m][n] = (f32x4){0.f, 0.f, 0.f, 0.f};
    bf16x8 At[4][2], B0[2][2], B1[2][2];
    const char* cA = (const char*)g.A + (size_t)cur.pm * tstep; const char* cB = (const char*)g.Bt + (size_t)cur.pn * tstep;
    S.a_ready(cur);
    if constexpr (SP2) {
        PG8_STAGE(PG8_SB(0, 0), cB, voffB); PG8_STAGE(PG8_SB(0, 1), cB + hstep, voffB); PG8_STAGE(PG8_SA(0, 0), cA, voffA); PG8_STAGE(PG8_SA(0, 1), cA + hstep, voffA);
        if (wr == 1) PG8_BAR;
        PG8_WAIT_V(2); PG8_BAR;
        PG8_STAGE(PG8_SB(1, 0), cB + kstep, voffB); PG8_STAGE(PG8_SA(1, 0), cA + kstep, voffA); PG8_STAGE(PG8_SB(1, 1), cB + hstep + kstep, voffB);
        PG8_WAIT_V(6); PG8_BAR;
    } else {
        PG8_STAGE(PG8_SB(0, 0), cB, voffB); PG8_STAGE(PG8_SA(0, 0), cA, voffA); PG8_STAGE(PG8_SB(0, 1), cB + hstep, voffB); PG8_STAGE(PG8_SA(0, 1), cA + hstep, voffA);
        if (wr == 1) PG8_BAR;
        PG8_WAIT_V(4); PG8_BAR;
        PG8_STAGE(PG8_SB(1, 0), cB + kstep, voffB); PG8_STAGE(PG8_SA(1, 0), cA + kstep, voffA); PG8_STAGE(PG8_SB(1, 1), cB + hstep + kstep, voffB);
        PG8_WAIT_V(6); PG8_BAR;
    }
    for (;;) {
        const bool has_next = S.next(ui + 1, nxt);
        const char* nA = has_next ? (const char*)g.A + (size_t)nxt.pm * tstep : cA; const char* nB = has_next ? (const char*)g.Bt + (size_t)nxt.pn * tstep : cB;
        for (int t = 0; t < nt; t += 2) {
            const bool last = (t == nt - 2);
            const char* a1 = cA + (size_t)(t + 1) * kstep;
            const char* a2 = last ? nA : cA + (size_t)(t + 2) * kstep; const char* b2 = last ? nB : cB + (size_t)(t + 2) * kstep;
            const char* a3 = a2 + kstep; const char* b3 = b2 + kstep;
            if (last && has_next) S.a_ready(nxt);
            if constexpr (SP2) {
            PG8_LDB(B0, 0, 0); PG8_LDB(B1, 0, 1); PG8_SCHED; PG8_LDA(At, 0, 0); PG8_STAGE(PG8_SA(1, 1), a1 + hstep, voffA);
            PG8_WAIT_V(8); PG8_WAIT_L(0); PG8_BAR; PG8_MMA(0, 0, At, B0); PG8_MMA(0, 1, At, B1); PG8_BAR; PG8_SCHED;
            PG8_LDA(At, 0, 1); PG8_STAGE(PG8_SB(0, 0), b2, voffB); PG8_STAGE(PG8_SB(0, 1), b2 + hstep, voffB); PG8_STAGE(PG8_SA(0, 0), a2, voffA);
            PG8_WAIT_V(8); PG8_WAIT_L(0); PG8_BAR; PG8_MMA(1, 0, At, B0); PG8_MMA(1, 1, At, B1); PG8_BAR; PG8_SCHED;
            PG8_LDB(B0, 1, 0); PG8_LDB(B1, 1, 1); PG8_SCHED; PG8_LDA(At, 1, 0); PG8_STAGE(PG8_SA(0, 1), a2 + hstep, voffA);
            PG8_WAIT_V(8); PG8_WAIT_L(0); PG8_BAR; PG8_MMA(0, 0, At, B0); PG8_MMA(0, 1, At, B1); PG8_BAR; PG8_SCHED;
            PG8_LDA(At, 1, 1); PG8_STAGE(PG8_SB(1, 0), b3, voffB); PG8_STAGE(PG8_SB(1, 1), b3 + hstep, voffB); PG8_STAGE(PG8_SA(1, 0), a3, voffA);
            PG8_WAIT_V(8); PG8_WAIT_L(0); PG8_BAR; PG8_MMA(1, 0, At, B0); PG8_MMA(1, 1, At, B1); PG8_BAR; PG8_SCHED;
            } else {
            PG8_LDB(B0, 0, 0); PG8_SCHED; PG8_LDA(At, 0, 0); PG8_STAGE(PG8_SA(1, 1), a1 + hstep, voffA);
            PG8_WAIT_L(8); PG8_BAR; PG8_WAIT_L(0); PG8_MMA(0, 0, At, B0); PG8_BAR; PG8_SCHED;
            PG8_LDB(B1, 0, 1); PG8_STAGE(PG8_SB(0, 0), b2, voffB);
            PG8_BAR; PG8_WAIT_L(0); PG8_MMA(0, 1, At, B1); PG8_BAR;
            PG8_LDA(At, 0, 1); PG8_STAGE(PG8_SA(0, 0), a2, voffA);
            PG8_BAR; PG8_WAIT_L(0); PG8_MMA(1, 0, At, B0); PG8_BAR; PG8_SCHED;
            PG8_STAGE(PG8_SB(0, 1), b2 + hstep, voffB);
            PG8_WAIT_V(6); PG8_BAR; PG8_MMA(1, 1, At, B1); PG8_BAR;
            PG8_LDB(B0, 1, 0); PG8_SCHED; PG8_LDA(At, 1, 0); PG8_STAGE(PG8_SA(0, 1), a2 + hstep, voffA);
            PG8_WAIT_L(8); PG8_BAR; PG8_WAIT_L(0); PG8_MMA(0, 0, At, B0); PG8_BAR; PG8_SCHED;
            PG8_LDB(B1, 1, 1); PG8_STAGE(PG8_SB(1, 0), b3, voffB);
            PG8_BAR; PG8_WAIT_L(0); PG8_MMA(0, 1, At, B1); PG8_BAR;
            PG8_LDA(At, 1, 1); PG8_STAGE(PG8_SA(1, 0), a3, voffA);
            PG8_BAR; PG8_WAIT_L(0); PG8_MMA(1, 0, At, B0); PG8_BAR; PG8_SCHED;
            PG8_STAGE(PG8_SB(1, 1), b3 + hstep, voffB);
            PG8_WAIT_V(6); PG8_BAR; PG8_MMA(1, 1, At, B1); PG8_BAR;
            }
        }
        if constexpr (ALIGN_EPI) { if (wr == 0) PG8_BAR; }
        if constexpr (!Epi::AFTER_DRAIN) { E(acc, cur, wr, wc, fr, fq); S.done(cur); }
        if (!has_next) break;
#pragma unroll
        for (int a = 0; a < 2; ++a)
#pragma unroll
            for (int b = 0; b < 2; ++b)
#pragma unroll
                for (int m = 0; m < 4; ++m)
#pragma unroll
                    for (int n = 0; n < 2; ++n) acc[a][b][m][n] = (f32x4){0.f, 0.f, 0.f, 0.f};
        cur = nxt; cA = nA; cB = nB; ++ui;
        if constexpr (ALIGN_EPI) { if (wr == 1) PG8_BAR; }
    }
    PG8_WAIT_V(0);
    if constexpr (!ALIGN_EPI) { if (wr == 0) PG8_BAR; }
    PG8_BAR;
    if constexpr (Epi::AFTER_DRAIN) { E.fused(acc, cur, wr, wc, fr, fq, lds, wid, lane); S.done(cur); }
#undef PG8_SA
#undef PG8_SB
#undef PG8_STAGE
#undef PG8_LDA
#undef PG8_LDB
#undef PG8_MMA
#undef PG8_WAIT_V
#undef PG8_WAIT_L
#undef PG8_BAR
#undef PG8_SCHED
}
}

#define LAS __attribute__((address_space(3)))
typedef unsigned short bf16_t;
typedef unsigned v4u __attribute__((ext_vector_type(4)));
typedef unsigned v2u __attribute__((ext_vector_type(2)));
typedef float f32x4 __attribute__((ext_vector_type(4)));
typedef float f32x16 __attribute__((ext_vector_type(16)));
typedef short bf16x8 __attribute__((ext_vector_type(8)));
typedef short s16x4 __attribute__((ext_vector_type(4)));

constexpr int NWAVES = 8, NTHR = 512;
constexpr int BATCH = 2, SEQ = 8192, DM = 1024, M = BATCH * SEQ;
constexpr int DIN = 1704;
constexpr int NPROJ = 2304;
constexpr int C_QL = 0, C_CKV = 1024, C_IQ = 1152, C_IK = 1408, C_IW = 1440, C_UP = 1448, C_UC = 1704, C_END = 2216;
constexpr int KMIX = 1536;
constexpr int NE = 16, DE = 512;
constexpr int MAXSLOT = 36864;
constexpr float ALPHA = 1.41421356237309515f, LN_EPS = 1e-5f;
constexpr int TOPK = 256;

constexpr size_t MiB = 1u << 20;
constexpr size_t WS_BLKCNT = 0;
constexpr size_t WS_TILETAB = 64 * 1024;
constexpr size_t WS_BAR = 128 * 1024;
constexpr size_t WS_SSQ = 1 * MiB;
constexpr size_t WS_TOKE = 2 * MiB;
constexpr size_t WS_TOKG = 2 * MiB + 256 * 1024;
constexpr size_t WS_TOKS = 2 * MiB + 512 * 1024;
constexpr size_t WS_GSLOT = 3 * MiB;
constexpr size_t WS_WPT = 3 * MiB + 512 * 1024;
constexpr size_t WS_WIN = 4 * MiB;
constexpr size_t WS_WO = 9 * MiB;
constexpr size_t WS_WGU = 12 * MiB;
constexpr size_t WS_WD = 44 * MiB;
constexpr size_t WS_XB = 60 * MiB;
constexpr size_t WS_R = 92 * MiB;
constexpr size_t WS_PROJ = WS_R;
constexpr size_t WS_YMIX = WS_R + 72 * MiB;
constexpr size_t WS_XS = WS_R;
constexpr size_t WS_H = WS_R + 72 * MiB;
constexpr size_t WS_IKC = WS_R + 120 * MiB;
constexpr size_t WS_CKVC = WS_R + 121 * MiB;
constexpr size_t WS_REC = WS_WGU;
constexpr size_t WS_END = WS_R + 125 * MiB;
static_assert(WS_REC + (size_t)2048 * 4 * 1536 * 6 <= WS_XB + (size_t)32 * MiB, "record overlay");

constexpr int LDS_BYTES = 147456;
constexpr int LDS_MISC = 143360;

#define LDS_WAIT() asm volatile("s_waitcnt lgkmcnt(0)" ::: "memory")
#define VM_WAIT() asm volatile("s_waitcnt vmcnt(0)" ::: "memory")

__device__ __forceinline__ unsigned f2bf(float f) { unsigned u = __builtin_bit_cast(unsigned, f); return (u + 0x7fffu + ((u >> 16) & 1u)) >> 16; }
__device__ __forceinline__ unsigned pk2(float lo, float hi) { return f2bf(lo) | (f2bf(hi) << 16); }
__device__ __forceinline__ float bflo(unsigned w) { return __builtin_bit_cast(float, w << 16); }
__device__ __forceinline__ float bfhi(unsigned w) { return __builtin_bit_cast(float, w & 0xffff0000u); }
__device__ __forceinline__ float bf2f(bf16_t v) { return __builtin_bit_cast(float, (unsigned)v << 16); }
__device__ __forceinline__ int ld_agent(const int* p) { return __hip_atomic_load(p, __ATOMIC_RELAXED, __HIP_MEMORY_SCOPE_AGENT); }
__device__ __forceinline__ float ld_agent_f(const float* p) { return __hip_atomic_load(p, __ATOMIC_RELAXED, __HIP_MEMORY_SCOPE_AGENT); }
__device__ __forceinline__ float wave_sum(float v) {
#pragma unroll
    for (int o = 1; o < 64; o <<= 1) v += __shfl_xor(v, o);
    return v;
}
__device__ __forceinline__ float sigmoidf_(float x) { return 1.0f / (1.0f + __expf(-x)); }

#define RLX_AGENT __ATOMIC_RELAXED, __HIP_MEMORY_SCOPE_AGENT
#define XB_TMO      128
#define XB_XCNT(j)  (256  + 64 * (j))
#define XB_XSUB(j)  (1280 + 64 * (j))
#define XB_XGEN(j)  (2304 + 64 * (j))
#define XB_TOP      3328
#define XB_TOPGEN   3392
#define XCD_BAR_WORDS 3456
#define XB_SPIN_CAP (1u << 18)

__device__ __forceinline__ unsigned xb_ld(unsigned* p)              { return __hip_atomic_load(p, __ATOMIC_RELAXED, __HIP_MEMORY_SCOPE_AGENT); }
__device__ __forceinline__ unsigned xb_add(unsigned* p, unsigned v) { return __hip_atomic_fetch_add(p, v, __ATOMIC_RELAXED, __HIP_MEMORY_SCOPE_AGENT); }
__device__ __forceinline__ unsigned xb_xcc_id() { return (unsigned)__builtin_amdgcn_s_getreg((3 << 11) | 20) & 0xFu; }
#define XB_SPIN(cond, bar) do { unsigned _sp = 0; while (cond) { __builtin_amdgcn_s_sleep(1); \
    if ((++_sp & 255u) == 0u) { if (xb_ld(&(bar)[XB_TMO])) break; if (_sp > XB_SPIN_CAP) { atomicAdd(&(bar)[XB_TMO], 1u); break; } } } } while (0)

struct XcdBarrier {
    unsigned* bar; unsigned x;
    volatile LAS unsigned* st;
};

__device__ __forceinline__ XcdBarrier xcd_barrier_post(unsigned* bar, volatile LAS unsigned* st) {
    XcdBarrier b; b.bar = bar; b.x = xb_xcc_id(); b.st = st;
    if (threadIdx.x == 0) (void)xb_add(&bar[XB_XCNT(b.x)], 1u);
    return b;
}
__device__ __forceinline__ void xcd_barrier_complete(unsigned* bar, unsigned x, unsigned& nloc, unsigned& nx) {
    const unsigned G = gridDim.x * gridDim.y * gridDim.z;
    unsigned sum, cnt, mine, sp = 0u;
    for (;;) {
        sum = 0u; cnt = 0u; mine = 0u;
#pragma unroll
        for (unsigned j = 0; j < 16; ++j) { const unsigned c = xb_ld(&bar[XB_XCNT(j)]); sum += c; cnt += (c > 0u) ? 1u : 0u; mine = (j == x) ? c : mine; }
        if (sum == G) break;
        __builtin_amdgcn_s_sleep(1);
        if ((++sp & 255u) == 0u) { if (xb_ld(&bar[XB_TMO])) break; if (sp > XB_SPIN_CAP) { atomicAdd(&bar[XB_TMO], 1u); break; } }
    }
    nloc = mine > 0u ? mine : 1u; nx = cnt > 0u ? cnt : 1u;
}

__device__ __forceinline__ void xcd_barrier(const XcdBarrier& b) {
    asm volatile("s_waitcnt vmcnt(0)" ::: "memory");
    __syncthreads();
    if (threadIdx.x == 0) {
        unsigned* bar = b.bar;
        __builtin_amdgcn_s_waitcnt(0);
        unsigned nloc = b.st[0], nx = b.st[1];
        if (nloc == 0u) { xcd_barrier_complete(bar, b.x, nloc, nx); b.st[0] = nloc; b.st[1] = nx; }
        const unsigned old = xb_add(&bar[XB_XSUB(b.x)], 1u);
        const unsigned gen = old / nloc;
        if (old + 1u == (gen + 1u) * nloc) {
            __builtin_amdgcn_fence(__ATOMIC_RELEASE, "agent");
            asm volatile("s_waitcnt vmcnt(0)" ::: "memory");
            const unsigned og = xb_add(&bar[XB_TOP], 1u);
            const unsigned tg = og / nx;
            if (og + 1u == (tg + 1u) * nx) xb_add(&bar[XB_TOPGEN], 1u);
            else XB_SPIN(xb_ld(&bar[XB_TOPGEN]) == tg, bar);
            __builtin_amdgcn_fence(__ATOMIC_ACQUIRE, "agent");
            xb_add(&bar[XB_XGEN(b.x)], 1u);
            asm volatile("s_waitcnt vmcnt(0)" ::: "memory");
        } else {
            XB_SPIN(xb_ld(&bar[XB_XGEN(b.x)]) == gen, bar);
            __builtin_amdgcn_fence(__ATOMIC_ACQUIRE, "agent");
            asm volatile("s_waitcnt vmcnt(0)" ::: "memory");
        }
    }
    __syncthreads();
}

struct Args {
    const float* in[21]; float* out; unsigned char* ws; int ph_lo, ph_hi, coop, pad;
};

struct Frame {
    LAS unsigned char* lds;
    int tid, lane, wave, G, bid;
};
__device__ __forceinline__ Frame relaunder(const Frame& F) { Frame L = F; int t = threadIdx.x; asm volatile("" : "+v"(t)); L.tid = t; L.lane = t & 63; L.wave = __builtin_amdgcn_readfirstlane(t >> 6); return L; }
typedef const __attribute__((address_space(4))) Args* KArgs;
__device__ __forceinline__ KArgs kargs() { KArgs p = (KArgs)__builtin_amdgcn_kernarg_segment_ptr(); asm volatile("" : "+s"(p)); return p; }
struct LayerW {
    const float *w_in, *kvg, *w_uk, *w_uv, *w_o, *w_gate, *w_up, *w_down;
};
__device__ __forceinline__ bf16_t* ws_bf(KArgs A, size_t off) { return (bf16_t*)(A->ws + off); }

struct EpiProj {
    static constexpr bool PERM = false, AFTER_DRAIN = false;
    bf16_t* O; float* ssq; bf16_t* ikc; bf16_t* ckvc;
    __device__ __forceinline__ void operator()(const f32x4 (&acc)[2][2][4][2], const pg8::Unit& u, int wr, int wc, int fr, int fq) const {
        const int col0 = u.pn * 256 + wc * 32 + 4 * fq;
#pragma unroll
        for (int ai = 0; ai < 2; ++ai)
#pragma unroll
            for (int m = 0; m < 4; ++m) {
                const int row = u.pm * 256 + ai * 128 + wr * 64 + m * 16 + fr;
                bf16_t* rowp = O + (size_t)row * NPROJ + col0;
#pragma unroll
                for (int bj = 0; bj < 2; ++bj)
#pragma unroll
                    for (int n = 0; n < 2; ++n) { const f32x4 v = acc[ai][bj][m][n]; v2u w; w.x = pk2(v[0], v[1]); w.y = pk2(v[2], v[3]); *(v2u*)(rowp + bj * 128 + n * 16) = w; }
                if (u.pn == 4) {
                    float ss = 0.f;
#pragma unroll
                    for (int n = 0; n < 2; ++n) { const f32x4 v = acc[ai][0][m][n]; ss += (v[0] * v[0] + v[1] * v[1]) + (v[2] * v[2] + v[3] * v[3]); }
                    ss += __shfl_xor(ss, 16); ss += __shfl_xor(ss, 32);
                    if (fq == 0) ssq[(size_t)row * 4 + wc] = ss;
#pragma unroll
                    for (int n = 0; n < 2; ++n) { const f32x4 v = acc[ai][0][m][n]; v2u w; w.x = pk2(v[0], v[1]); w.y = pk2(v[2], v[3]); *(v2u*)(ckvc + (size_t)row * 128 + wc * 32 + n * 16 + 4 * fq) = w; }
                }
                if (u.pn == 5 && wc == 0) {
#pragma unroll
                    for (int n = 0; n < 2; ++n) { const f32x4 v = acc[ai][1][m][n]; v2u w; w.x = pk2(v[0], v[1]); w.y = pk2(v[2], v[3]); *(v2u*)(ikc + (size_t)row * 32 + n * 16 + 4 * fq) = w; }
                }
            }
    }
};
struct EpiMix {
    static constexpr bool PERM = false, AFTER_DRAIN = false;
    const float* base; float* out;
    __device__ __forceinline__ void operator()(const f32x4 (&acc)[2][2][4][2], const pg8::Unit& u, int wr, int wc, int fr, int fq) const {
        const int col0 = u.pn * 256 + wc * 32 + 4 * fq;
#pragma unroll
        for (int ai = 0; ai < 2; ++ai)
#pragma unroll
            for (int m = 0; m < 4; ++m) {
                const size_t off = (size_t)(u.pm * 256 + ai * 128 + wr * 64 + m * 16 + fr) * DM + col0;
#pragma unroll
                for (int bj = 0; bj < 2; ++bj)
#pragma unroll
                    for (int n = 0; n < 2; ++n) { const f32x4 b = *(const f32x4*)(base + off + bj * 128 + n * 16); *(f32x4*)(out + off + bj * 128 + n * 16) = b * ALPHA + acc[ai][bj][m][n]; }
                asm volatile("" ::: "memory");
            }
    }
};
struct EpiGU {
    static constexpr bool PERM = false, AFTER_DRAIN = false;
    bf16_t* H; const float* gslot;
    __device__ __forceinline__ void operator()(const f32x4 (&acc)[2][2][4][2], const pg8::Unit& u, int wr, int wc, int fr, int fq) const {
        const int f0 = (u.pn & 3) * 128 + wc * 16 + 4 * fq;
#pragma unroll
        for (int ai = 0; ai < 2; ++ai)
#pragma unroll
            for (int m = 0; m < 4; ++m) {
                const int row = u.pm * 256 + ai * 128 + wr * 64 + m * 16 + fr;
                const float gw = gslot[row];
#pragma unroll
                for (int bj = 0; bj < 2; ++bj) {
                    const f32x4 g = acc[ai][bj][m][0], up = acc[ai][bj][m][1]; float h[4];
#pragma unroll
                    for (int i = 0; i < 4; ++i) h[i] = g[i] * sigmoidf_(g[i]) * up[i] * gw;
                    v2u w; w.x = pk2(h[0], h[1]); w.y = pk2(h[2], h[3]); *(v2u*)(H + (size_t)row * DE + f0 + bj * 64) = w;
                }
                asm volatile("" ::: "memory");
            }
    }
};
struct EpiDown {
    static constexpr bool PERM = false, AFTER_DRAIN = false;
    bf16_t* Y;
    __device__ __forceinline__ void operator()(const f32x4 (&acc)[2][2][4][2], const pg8::Unit& u, int wr, int wc, int fr, int fq) const {
        const int col0 = (u.pn & 3) * 256 + wc * 32 + 4 * fq;
#pragma unroll
        for (int ai = 0; ai < 2; ++ai)
#pragma unroll
            for (int m = 0; m < 4; ++m) {
                bf16_t* rowp = Y + (size_t)(u.pm * 256 + ai * 128 + wr * 64 + m * 16 + fr) * DM + col0;
#pragma unroll
                for (int bj = 0; bj < 2; ++bj)
#pragma unroll
                    for (int n = 0; n < 2; ++n) { const f32x4 v = acc[ai][bj][m][n]; v2u w; w.x = pk2(v[0], v[1]); w.y = pk2(v[2], v[3]); *(v2u*)(rowp + bj * 128 + n * 16) = w; }
            }
    }
};
struct GroupedOrder {
    const int* tab; int G, c, nunits;
    __device__ __forceinline__ void init(const int* tab_, int G_, int c_) { tab = tab_; G = G_; c = c_; nunits = ld_agent(tab_) * 4; }
    __device__ __forceinline__ bool next(int i, pg8::Unit& u) const {
        const int L = i * G + c; if (L >= nunits) return false;
        const int pm = L >> 2; const int e = ld_agent(tab + 1 + pm); u.pm = pm; u.pn = e * 4 + (L & 3); return true;
    }
    __device__ __forceinline__ void a_ready(const pg8::Unit&) const {}
    __device__ __forceinline__ void done(const pg8::Unit&) const {}
};

struct RowId { __device__ __forceinline__ int operator()(int n) const { return n; } };
struct RowGU { int up; __device__ __forceinline__ int operator()(int n) const { return 32 * (n >> 4) + (n & 15) + 16 * up; } };

template <class RM>
__device__ __forceinline__ void transpose_item(const float* W, int ldw, int krow0, int col0, int ncols, bf16_t* WT, int pitch, int koff, RM rm, int item, int lane) {
    const int nblk = (ncols + 63) >> 6, kb = item / nblk, nb = item - kb * nblk, k0 = 64 * kb, n = 64 * nb + lane;
    if (n >= ncols) return;
    const float* src = W + (size_t)(krow0 + k0) * ldw + col0 + n;
    bf16_t* dst = WT + (size_t)rm(n) * pitch + koff + k0;
#pragma unroll 2
    for (int c = 0; c < 8; ++c) {
        float v[8];
#pragma unroll
        for (int q = 0; q < 8; ++q) v[q] = src[(size_t)(8 * c + q) * ldw];
        v4u o; o.x = pk2(v[0], v[1]); o.y = pk2(v[2], v[3]); o.z = pk2(v[4], v[5]); o.w = pk2(v[6], v[7]);
        *(v4u*)(dst + 8 * c) = o;
    }
}

__device__ __forceinline__ void absorb_q_task(const Frame& F, const float* w_in, const float* w_uk, const float* kvg, bf16_t* Win_t, int a) {
    const int h = a >> 6, kb = (a >> 2) & 15, rq = a & 3, k = kb * 64 + F.lane;
    f32x4 win[16];
    const f32x4* src = (const f32x4*)(w_in + (size_t)k * DIN + h * 64);
#pragma unroll
    for (int i = 0; i < 16; ++i) win[i] = src[i];
#pragma unroll 1
    for (int r = rq * 32; r < rq * 32 + 32; ++r) {
        const f32x4* wu = (const f32x4*)(w_uk + (size_t)(h * 128 + r) * 64);
        float acc = 0.f;
#pragma unroll
        for (int i = 0; i < 16; ++i) { const f32x4 u = wu[i]; acc += win[i][0] * u[0]; acc += win[i][1] * u[1]; acc += win[i][2] * u[2]; acc += win[i][3] * u[3]; }
        Win_t[(size_t)(h * 128 + r) * DM + k] = (bf16_t)f2bf(acc * 0.125f * kvg[r]);
    }
}
__device__ __forceinline__ void absorb_o_task(const Frame& F, const float* w_o, const float* w_uv, const float* kvg, bf16_t* Wo_t, int a) {
    const int h = a >> 6, nb = (a >> 2) & 15, rq = a & 3, n = nb * 64 + F.lane;
    float wo[64];
#pragma unroll
    for (int d = 0; d < 64; ++d) wo[d] = w_o[(size_t)(h * 64 + d) * DM + n];
#pragma unroll 1
    for (int r = rq * 32; r < rq * 32 + 32; ++r) {
        const f32x4* wu = (const f32x4*)(w_uv + (size_t)(h * 128 + r) * 64);
        float s = 0.f;
#pragma unroll
        for (int i = 0; i < 16; ++i) { const f32x4 u = wu[i]; s += wo[4 * i] * u[0]; s += wo[4 * i + 1] * u[1]; s += wo[4 * i + 2] * u[2]; s += wo[4 * i + 3] * u[3]; }
        Wo_t[(size_t)n * KMIX + h * 128 + r] = (bf16_t)f2bf(s * kvg[r]);
    }
}

__device__ __forceinline__ void phase_convert(const Frame& F0, int l, bool with_x, int part) {
    const Frame F = relaunder(F0);
    KArgs A = kargs();
    const float* w_in = A->in[1] + (size_t)l * DM * DIN; const float* kvg = A->in[2] + l * 128;
    const float* w_uk = A->in[3] + (size_t)l * 8 * 128 * 64; const float* w_uv = A->in[4] + (size_t)l * 8 * 128 * 64;
    const float* w_o = A->in[11] + (size_t)l * DM * DM;
    const float* w_gate = A->in[16] + (size_t)l * NE * DM * DE; const float* w_up = A->in[17] + (size_t)l * NE * DM * DE; const float* w_down = A->in[18] + (size_t)l * NE * DE * DM;
    bf16_t* Win_t = ws_bf(A, WS_WIN); bf16_t* Wo_t = ws_bf(A, WS_WO); bf16_t* Wgu_t = ws_bf(A, WS_WGU); bf16_t* Wd_t = ws_bf(A, WS_WD);
    const int gw = F.bid * NWAVES + F.wave, NGW = F.G * NWAVES;
    constexpr int I_AQ = 512, I_AO = 512, I_IN = 16 * 19, I_O2 = 8 * 16, I_G1 = 16 * 8, I_D1 = 8 * 16, I_Z = 88, I_WP = 4;
    constexpr int NITEMS = I_AQ + I_AO + I_IN + I_O2 + NE * (2 * I_G1 + I_D1) + I_Z + I_WP;
    constexpr int I_A = I_AQ + I_AO + I_IN + I_O2, I_MOE = NE * (2 * I_G1 + I_D1);
    const int it_lo = part == 0 ? 0 : I_A, it_hi = part == 0 ? NITEMS : I_A + I_MOE;
#pragma unroll 1
    for (int it = it_lo + gw; it < it_hi; it += NGW) {
        if (part == 0 && it >= I_A && it < I_A + I_MOE) continue;
        int r = it;
#ifndef NO_AQ
        if (r < I_AQ) { absorb_q_task(F, w_in, w_uk, kvg, Win_t, r); continue; }
#endif
        r -= I_AQ;
#ifndef NO_AO
        if (r < I_AO) { absorb_o_task(F, w_o, w_uv, kvg, Wo_t, r); continue; }
#endif
        r -= I_AO;
        if (r < I_IN) { transpose_item(w_in, DIN, 0, 512, DIN - 512, Win_t + (size_t)1024 * DM, DM, 0, RowId{}, r, F.lane); continue; } r -= I_IN;
        if (r < I_O2) { transpose_item(w_o, DM, 512, 0, DM, Wo_t, KMIX, 1024, RowId{}, r, F.lane); continue; } r -= I_O2;
        if (r < NE * 2 * I_G1) { const int e = r / (2 * I_G1), q = r % (2 * I_G1), up = q / I_G1, item = q % I_G1;
            transpose_item((up ? w_up : w_gate) + (size_t)e * DM * DE, DE, 0, 0, DE, Wgu_t + (size_t)e * 1024 * DM, DM, 0, RowGU{up}, item, F.lane); continue; } r -= NE * 2 * I_G1;
        if (r < NE * I_D1) { const int e = r / I_D1, item = r % I_D1;
            transpose_item(w_down + (size_t)e * DE * DM, DM, 0, 0, DM, Wd_t + (size_t)e * 1024 * DE, DE, 0, RowId{}, item, F.lane); continue; } r -= NE * I_D1;
        if (r < I_Z) { v4u z = {0u, 0u, 0u, 0u}; v4u* p = (v4u*)(Win_t + (size_t)(C_END + r) * DM); p[F.lane] = z; p[F.lane + 64] = z; continue; } r -= I_Z;
        transpose_item(A->in[5] + (size_t)l * 4 * 64 * 64 + (size_t)r * 64 * 64, 64, 0, 0, 64, ws_bf(A, WS_WPT) + (size_t)r * 64 * 64, 64, 0, RowId{}, 0, F.lane);
    }
    if (with_x) {
        const float* x = A->in[0]; bf16_t* xb = ws_bf(A, WS_XB);
#pragma unroll 1
        for (int m = gw; m < M; m += NGW) {
            const f32x4* xr = (const f32x4*)(x + (size_t)m * DM) + F.lane; v2u* o = (v2u*)(xb + (size_t)m * DM) + F.lane;
#pragma unroll
            for (int j = 0; j < 4; ++j) { const f32x4 v = xr[64 * j]; v2u w; w.x = pk2(v[0], v[1]); w.y = pk2(v[2], v[3]); o[64 * j] = w; }
        }
    }
}

struct MixP { unsigned* rec; const bf16_t* proj; const bf16_t* ikc; const bf16_t* ckvc; bf16_t* ymix; const bf16_t* wpt; const float *ssq, *conv_w, *conv_b, *cln_g, *cln_b, *pool_scale; };
__device__ __forceinline__ void conv_pool_tile(const Frame& F, const MixP& P, int tile) {
    const int tid = F.tid, lane = F.lane, wave = F.wave;
    const int row0 = tile * 32;
    const int tpos0 = row0 & (SEQ - 1);
    LAS float* hbuf = (LAS float*)F.lds;
    LAS float* cout = (LAS float*)(F.lds + 63488);
#pragma unroll 1
    for (int task = tid; task < 62 * 32; task += NTHR) {
        const int j = task >> 5, c8 = (task & 31) * 8; const int tp = tpos0 - 30 + j;
        f32x4 h0 = {0.f, 0.f, 0.f, 0.f}, h1 = {0.f, 0.f, 0.f, 0.f};
        if (tp >= 0) {
            const bf16_t* p = P.proj + (size_t)(row0 - 30 + j) * NPROJ + C_UC + c8;
            const v4u a = *(const v4u*)p, g = *(const v4u*)(p + 256);
            h0[0] = bflo(a.x) * sigmoidf_(bflo(g.x)); h0[1] = bfhi(a.x) * sigmoidf_(bfhi(g.x)); h0[2] = bflo(a.y) * sigmoidf_(bflo(g.y)); h0[3] = bfhi(a.y) * sigmoidf_(bfhi(g.y));
            h1[0] = bflo(a.z) * sigmoidf_(bflo(g.z)); h1[1] = bfhi(a.z) * sigmoidf_(bfhi(g.z)); h1[2] = bflo(a.w) * sigmoidf_(bflo(g.w)); h1[3] = bfhi(a.w) * sigmoidf_(bfhi(g.w));
        }
        *(LAS f32x4*)(hbuf + j * 256 + c8) = h0; *(LAS f32x4*)(hbuf + j * 256 + c8 + 4) = h1;
    }
    __syncthreads();
    {
        const int c = tid & 255, half = tid >> 8;
        float w[31], hv[46];
#pragma unroll
        for (int j = 0; j < 31; ++j) w[j] = P.conv_w[j * 256 + c];
#pragma unroll
        for (int j = 0; j < 46; ++j) hv[j] = hbuf[(16 * half + j) * 256 + c];
        const float bias = P.conv_b[c];
#pragma unroll
        for (int i = 0; i < 16; ++i) {
            float a0 = bias, a1 = 0.f;
#pragma unroll
            for (int j = 0; j < 30; j += 2) { a0 = fmaf(hv[i + j], w[j], a0); a1 = fmaf(hv[i + j + 1], w[j + 1], a1); }
            a0 = fmaf(hv[i + 30], w[30], a0);
            cout[(16 * half + i) * 256 + c] = a0 + a1;
        }
    }
    __syncthreads();
#pragma unroll 1
    for (int i = wave; i < 32; i += NWAVES) {
        const f32x4 x = *(LAS f32x4*)(cout + i * 256 + 4 * lane);
        const float mean = wave_sum((x[0] + x[1]) + (x[2] + x[3])) * (1.f / 256.f);
        const f32x4 d = x - mean;
        const float var = wave_sum((d[0] * d[0] + d[1] * d[1]) + (d[2] * d[2] + d[3] * d[3])) * (1.f / 256.f);
        const float rstd = 1.0f / sqrtf(var + LN_EPS);
        const f32x4 g = *(const f32x4*)(P.cln_g + 4 * lane), b = *(const f32x4*)(P.cln_b + 4 * lane);
        float y[4];
#pragma unroll
        for (int k = 0; k < 4; ++k) { const float z = d[k] * rstd * g[k] + b[k]; y[k] = z * sigmoidf_(z); }
        v2u w; w.x = pk2(y[0], y[1]); w.y = pk2(y[2], y[3]);
        *(v2u*)(P.ymix + (size_t)(row0 + i) * KMIX + 1280 + 4 * lane) = w;
    }
    __syncthreads();
    LAS float* pbuf = (LAS float*)F.lds; LAS unsigned char* plb = F.lds + 49152;
#pragma unroll 1
    for (int task = tid; task < 47 * 32; task += NTHR) {
        const int j = task >> 5, c8 = (task & 31) * 8; const int tp = tpos0 - 15 + j;
        f32x4 h0 = {0.f, 0.f, 0.f, 0.f}, h1 = {0.f, 0.f, 0.f, 0.f};
        if (tp >= 0) {
            const v4u a = *(const v4u*)(P.proj + (size_t)(row0 - 15 + j) * NPROJ + C_UP + c8);
            h0[0] = bflo(a.x); h0[1] = bfhi(a.x); h0[2] = bflo(a.y); h0[3] = bfhi(a.y); h1[0] = bflo(a.z); h1[1] = bfhi(a.z); h1[2] = bflo(a.w); h1[3] = bfhi(a.w);
        }
        *(LAS f32x4*)(pbuf + j * 256 + c8) = h0; *(LAS f32x4*)(pbuf + j * 256 + c8 + 4) = h1;
    }
    __syncthreads();
    {
        const int c = tid & 255, half = tid >> 8, gi = c >> 6, cl = c & 63, w = 2 << gi;
#pragma unroll 1
        for (int i = 0; i < 16; ++i) {
            const int t = half * 16 + i; float s = 0.f;
            for (int j = 0; j < w; ++j) s += pbuf[(t + 15 - j) * 256 + c];
            const int tp = tpos0 + t; const float cnt = (float)((tp + 1) < w ? (tp + 1) : w);
            const float v = s / cnt - pbuf[(t + 15) * 256 + c];
            *(LAS bf16_t*)(plb + gi * 4096 + t * 128 + (((cl >> 3) ^ (t & 7)) * 16) + (cl & 7) * 2) = (bf16_t)f2bf(v);
        }
    }
    __syncthreads();
    {
        const int g = wave >> 1, ct = wave & 1, r32 = lane & 31, kk = lane >> 5;
        f32x16 acc = {0.f, 0.f, 0.f, 0.f, 0.f, 0.f, 0.f, 0.f, 0.f, 0.f, 0.f, 0.f, 0.f, 0.f, 0.f, 0.f};
        const bf16_t* wb = P.wpt + (size_t)(g * 64 + ct * 32 + r32) * 64 + 8 * kk;
#pragma unroll
        for (int ks = 0; ks < 4; ++ks) {
            const bf16x8 a = *(LAS bf16x8*)(plb + g * 4096 + r32 * 128 + (((2 * ks + kk) ^ (r32 & 7)) * 16));
            const bf16x8 bfr = *(const bf16x8*)(wb + 16 * ks);
            acc = __builtin_amdgcn_mfma_f32_32x32x16_bf16(a, bfr, acc, 0, 0, 0);
        }
        const int d = g * 64 + ct * 32 + r32; const float sc = P.pool_scale[d];
#pragma unroll
        for (int r = 0; r < 16; ++r) { const int t = (r & 3) + 8 * (r >> 2) + 4 * kk; P.ymix[(size_t)(row0 + t) * KMIX + 1024 + d] = (bf16_t)f2bf(acc[r] * sc); }
    }
    __syncthreads();
}

__device__ __forceinline__ unsigned f2ord(float f) { const int x = __builtin_bit_cast(int, f); return (unsigned)x ^ ((unsigned)(x >> 31) | 0x80000000u); }
__device__ __forceinline__ float relu_i(float x) { const int i = __builtin_bit_cast(int, x); return __builtin_bit_cast(float, i > 0 ? i : 0); }

__device__ __forceinline__ void hist_scan(LAS unsigned* h, unsigned need, int lane, int& bin, unsigned& above, unsigned& binc) {
    const v4u c = *(LAS v4u*)(h + 4 * lane);
    const unsigned T = c.x + c.y + c.z + c.w;
    unsigned X = T;
#pragma unroll
    for (int o = 1; o < 64; o <<= 1) { const unsigned y = __shfl_down(X, o); if (lane + o < 64) X += y; }
    const unsigned long long mk = __ballot(X >= need);
    const int L = mk ? (63 - __clzll(mk)) : 0;
    const unsigned S3 = X - T + c.w, S2 = S3 + c.z, S1 = S2 + c.y;
    int bl; unsigned ab, bc;
    if (S3 >= need) { bl = 3; ab = X - T; bc = c.w; } else if (S2 >= need) { bl = 2; ab = S3; bc = c.z; } else if (S1 >= need) { bl = 1; ab = S2; bc = c.y; } else { bl = 0; ab = S1; bc = c.x; }
    bin = __shfl(4 * lane + bl, L); above = (unsigned)__shfl((int)ab, L); binc = (unsigned)__shfl((int)bc, L);
}
__device__ __forceinline__ void hist_scan512(LAS unsigned* h, unsigned need, int lane, int& bin, unsigned& above, unsigned& binc) {
    const v4u c0 = *(LAS v4u*)(h + 8 * lane), c1 = *(LAS v4u*)(h + 8 * lane + 4);
    const unsigned cc[8] = {c0.x, c0.y, c0.z, c0.w, c1.x, c1.y, c1.z, c1.w};
    const unsigned T = ((c0.x + c0.y) + (c0.z + c0.w)) + ((c1.x + c1.y) + (c1.z + c1.w));
    unsigned X = T;
#pragma unroll
    for (int o = 1; o < 64; o <<= 1) { const unsigned y = __shfl_down(X, o); if (lane + o < 64) X += y; }
    const unsigned long long mk = __ballot(X >= need);
    const int L = mk ? (63 - __clzll(mk)) : 0;
    unsigned S = X - T; int bl = 0; unsigned ab = S, bc = 0u; bool found = false;
#pragma unroll
    for (int k = 7; k >= 0; --k) { const unsigned Sn = S + cc[k]; if (!found && Sn >= need) { found = true; bl = k; ab = S; bc = cc[k]; } S = Sn; }
    bin = __shfl(8 * lane + bl, L); above = (unsigned)__shfl((int)ab, L); binc = (unsigned)__shfl((int)bc, L);
}

__device__ __forceinline__ int swz16(int row) { return ((row & 3) << 2) | ((row >> 2) & 3); }

constexpr int CAND_CAP = 256;
constexpr int WPRIV = 12800;
constexpr int RCAP = 1536;
#ifndef REP_IDX
#define REP_IDX 0
#endif
#ifndef REP_ATT
#define REP_ATT 0
#endif
#ifndef ABL_FLAGS
#define ABL_FLAGS 0
#endif

struct IdxState {
    unsigned prefix0, prefix1, need0, need1;
    unsigned eqt0, eqt1, cnt0, cnt1, cc0, cc1;
    unsigned blo0, blo1;
    unsigned rc0, rc1;
    float inv0, inv1, c00, c01;
    float ss0[8], ss1[8];
};
struct IdxConst {
    bf16x8 A0, A1; float wq[2][8]; int tqj0, tqj1; int hh, kl, rd0, rd1;
    LAS unsigned* hist; LAS unsigned short* sel; LAS unsigned* cand_u; LAS unsigned short* cand_i;
    int shift; unsigned himask; int abl;
    unsigned* rec_u; unsigned short* rec_i;
};
__device__ __forceinline__ unsigned lin_bin(float s, float inv, float c0) { return (unsigned)__builtin_amdgcn_fmed3f(fmaf(s, inv, c0), 0.f, 511.f); }

__device__ __forceinline__ void tile_scores(const IdxConst& C, const f32x16& acc, float& s0, float& s1) {
    float a0 = C.wq[0][0] * relu_i(acc[0]), b0 = C.wq[0][4] * relu_i(acc[4]), a1 = C.wq[1][0] * relu_i(acc[8]), b1 = C.wq[1][4] * relu_i(acc[12]);
#pragma unroll
    for (int h = 1; h < 4; ++h) { a0 = fmaf(C.wq[0][h], relu_i(acc[h]), a0); b0 = fmaf(C.wq[0][4 + h], relu_i(acc[4 + h]), b0); a1 = fmaf(C.wq[1][h], relu_i(acc[8 + h]), a1); b1 = fmaf(C.wq[1][4 + h], relu_i(acc[12 + h]), b1); }
    s0 = (a0 + b0) + 0.0f; s1 = (a1 + b1) + 0.0f;
}
template <int MODE>
__device__ __forceinline__ void tile_post(const IdxConst& C, IdxState& S, const f32x16& acc, int tile, int tl) {
    float s0, s1; tile_scores(C, acc, s0, s1);
    const int kidx = tile * 32 + C.kl;
    const bool v0 = kidx <= C.tqj0, v1 = kidx <= C.tqj1;
    const int hh = C.hh;
    if constexpr (MODE == 6) { S.ss0[tl] = s0; S.ss1[tl] = s1; }
    else if constexpr (MODE == 9) {
        const unsigned b0 = lin_bin(s0, S.inv0, S.c00), b1 = lin_bin(s1, S.inv1, S.c01);
        const unsigned ltm = (1u << C.kl) - 1u;
        {   const bool ps = v0 && (b0 >= S.blo0);
            if (ps) __hip_atomic_fetch_add(C.hist + (2 * hh) * 512 + b0, 1u, __ATOMIC_RELAXED, __HIP_MEMORY_SCOPE_WORKGROUP);
            const unsigned long long mt = __ballot(ps); const unsigned t32 = hh ? (unsigned)(mt >> 32) : (unsigned)mt;
            const unsigned pos = S.rc0 + __popc(t32 & ltm);
            if (ps && pos < (unsigned)RCAP && !(C.abl & 4)) { __builtin_nontemporal_store(__builtin_bit_cast(unsigned, s0), C.rec_u + (2 * hh) * RCAP + pos); __builtin_nontemporal_store((unsigned short)kidx, C.rec_i + (2 * hh) * RCAP + pos); }
            S.rc0 += __popc(t32); }
        {   const bool ps = v1 && (b1 >= S.blo1);
            if (ps) __hip_atomic_fetch_add(C.hist + (2 * hh + 1) * 512 + b1, 1u, __ATOMIC_RELAXED, __HIP_MEMORY_SCOPE_WORKGROUP);
            const unsigned long long mt = __ballot(ps); const unsigned t32 = hh ? (unsigned)(mt >> 32) : (unsigned)mt;
            const unsigned pos = S.rc1 + __popc(t32 & ltm);
            if (ps && pos < (unsigned)RCAP && !(C.abl & 4)) { __builtin_nontemporal_store(__builtin_bit_cast(unsigned, s1), C.rec_u + (2 * hh + 1) * RCAP + pos); __builtin_nontemporal_store((unsigned short)kidx, C.rec_i + (2 * hh + 1) * RCAP + pos); }
            S.rc1 += __popc(t32); }
    } else if constexpr (MODE == 0) {
        const unsigned u0 = f2ord(s0), u1 = f2ord(s1);
        if (v0 && ((u0 & C.himask) == S.prefix0)) __hip_atomic_fetch_add(C.hist + (2 * hh) * 256 + ((u0 >> C.shift) & 255u), 1u, __ATOMIC_RELAXED, __HIP_MEMORY_SCOPE_WORKGROUP);
        if (v1 && ((u1 & C.himask) == S.prefix1)) __hip_atomic_fetch_add(C.hist + (2 * hh + 1) * 256 + ((u1 >> C.shift) & 255u), 1u, __ATOMIC_RELAXED, __HIP_MEMORY_SCOPE_WORKGROUP);
    } else {
        const unsigned u0 = f2ord(s0), u1 = f2ord(s1);
        const unsigned ltm = (1u << C.kl) - 1u;
        {   const bool eq = v0 && (u0 == S.prefix0), gt = v0 && (u0 > S.prefix0);
            const unsigned long long me = __ballot(eq); const unsigned m32 = hh ? (unsigned)(me >> 32) : (unsigned)me;
            const bool take = gt || (eq && (S.eqt0 + __popc(m32 & ltm) < S.need0)); S.eqt0 += __popc(m32);
            const unsigned long long mt = __ballot(take); const unsigned t32 = hh ? (unsigned)(mt >> 32) : (unsigned)mt;
            const unsigned pos = S.cnt0 + __popc(t32 & ltm); if (take && pos < TOPK) C.sel[(2 * hh) * 256 + pos] = (unsigned short)kidx; S.cnt0 += __popc(t32); }
        {   const bool eq = v1 && (u1 == S.prefix1), gt = v1 && (u1 > S.prefix1);
            const unsigned long long me = __ballot(eq); const unsigned m32 = hh ? (unsigned)(me >> 32) : (unsigned)me;
            const bool take = gt || (eq && (S.eqt1 + __popc(m32 & ltm) < S.need1)); S.eqt1 += __popc(m32);
            const unsigned long long mt = __ballot(take); const unsigned t32 = hh ? (unsigned)(mt >> 32) : (unsigned)mt;
            const unsigned pos = S.cnt1 + __popc(t32 & ltm); if (take && pos < TOPK) C.sel[(2 * hh + 1) * 256 + pos] = (unsigned short)kidx; S.cnt1 += __popc(t32); }
    }
}
__device__ __forceinline__ f32x16 tile_mfma(const IdxConst& C, LAS unsigned char* buf, int tl) {
    const bf16x8 B0 = *(LAS bf16x8*)(buf + tl * 2048 + C.rd0), B1 = *(LAS bf16x8*)(buf + tl * 2048 + C.rd1);
    f32x16 a = {0.f, 0.f, 0.f, 0.f, 0.f, 0.f, 0.f, 0.f, 0.f, 0.f, 0.f, 0.f, 0.f, 0.f, 0.f, 0.f};
    a = __builtin_amdgcn_mfma_f32_32x32x16_bf16(C.A0, B0, a, 0, 0, 0);
    return __builtin_amdgcn_mfma_f32_32x32x16_bf16(C.A1, B1, a, 0, 0, 0);
}
template <int MODE>
__device__ __forceinline__ void idx_sweep(const IdxConst& C, IdxState& S, LAS unsigned char* ikbuf, const bf16_t* ikb, int tid, int ntile, int nchunk, int nkeys, int sstride) {
    constexpr bool sample = (MODE == 6);
    const int sr0 = tid >> 2, sc = tid & 3;
    const int sdst0 = sr0 * 64 + ((sc ^ ((sr0 >> 2) & 3)) * 16), sdst1 = (sr0 + 128) * 64 + ((sc ^ (((sr0 + 128) >> 2) & 3)) * 16);
    const int nch = sample ? 1 : nchunk;
    v4u sa = {0u, 0u, 0u, 0u}, sb = {0u, 0u, 0u, 0u};
    {   const int ka = sample ? ((sr0 >> 5) * sstride * 32 + (sr0 & 31)) : sr0, kb = sample ? ((((sr0 + 128) >> 5) * sstride) * 32 + (sr0 & 31)) : (sr0 + 128);
        if (ka < nkeys) sa = *(const v4u*)(ikb + (size_t)ka * 32 + sc * 8);
        if (kb < nkeys) sb = *(const v4u*)(ikb + (size_t)kb * 32 + sc * 8); }
    *(LAS v4u*)(ikbuf + sdst0) = sa; *(LAS v4u*)(ikbuf + sdst1) = sb;
    __syncthreads();
#pragma unroll 1
    for (int ci = 0; ci < nch; ++ci) {
        const bool more = (ci + 1) < nch;
        if (more) { const int k0 = (ci + 1) * 256;
            sa = (v4u){0u, 0u, 0u, 0u}; sb = sa;
            if (k0 + sr0 < nkeys) sa = *(const v4u*)(ikb + (size_t)(k0 + sr0) * 32 + sc * 8);
            if (k0 + sr0 + 128 < nkeys) sb = *(const v4u*)(ikb + (size_t)(k0 + sr0 + 128) * 32 + sc * 8); }
        LAS unsigned char* buf = ikbuf + (ci & 1) * 16384;
        f32x16 accA = tile_mfma(C, buf, 0), accB;
#pragma unroll
        for (int tl = 0; tl < 8; tl += 2) {
            accB = tile_mfma(C, buf, tl + 1);
            tile_post<MODE>(C, S, accA, ci * 8 + tl, tl);
            if (tl + 2 < 8) accA = tile_mfma(C, buf, tl + 2);
            tile_post<MODE>(C, S, accB, ci * 8 + tl + 1, tl + 1);
        }
        if (more) { LAS unsigned char* nb = ikbuf + ((ci + 1) & 1) * 16384; *(LAS v4u*)(nb + sdst0) = sa; *(LAS v4u*)(nb + sdst1) = sb; }
        __syncthreads();
    }
}

__device__ __forceinline__ void dsa_group(const Frame& F, const MixP& P, int b, int t0) {
    int tid_ = F.tid; asm volatile("" : "+v"(tid_));
    const int tid = tid_, lane = tid & 63, w = F.wave, hh = lane >> 5, kl = lane & 31;
    LAS unsigned char* ikbuf = F.lds;
    LAS unsigned char* wl = F.lds + 32768 + w * WPRIV;
    LAS unsigned short* sel = (LAS unsigned short*)wl;
    LAS unsigned* hist = (LAS unsigned*)(wl + 2048);
    LAS unsigned char* cbuf = wl + 2048;
    LAS unsigned* cand_u = (LAS unsigned*)(wl + 2048);
    LAS unsigned short* cand_i = (LAS unsigned short*)(wl + 2048 + 4096);
    LAS bf16_t* obuf = (LAS bf16_t*)(wl + 10240);
    LAS float* rsbuf = (LAS float*)(wl + 12544);
    LAS unsigned* flag = (LAS unsigned*)(F.lds + LDS_MISC + 256);
    const bf16_t* projb = P.proj + (size_t)b * SEQ * NPROJ;
    const bf16_t* ikb = P.ikc + (size_t)b * SEQ * 32;
    const bf16_t* ckvb = P.ckvc + (size_t)b * SEQ * 128;
    const float* ssqb = P.ssq + (size_t)b * SEQ * 4;
    const int tq0 = t0 + 4 * w;

    for (int repi = 0; repi < 1 + REP_IDX; ++repi)
    if (t0 >= TOPK) {
        IdxConst C; IdxState S;
        C.abl = (repi < REP_IDX) ? ABL_FLAGS : 0;
        { const int r = kl, qa = 2 * ((r >> 2) & 1) + (r >> 4), head = (r & 3) + 4 * ((r >> 3) & 1);
          const bf16_t* ap = projb + (size_t)(tq0 + qa) * NPROJ + C_IQ + head * 32 + 8 * hh;
          C.A0 = *(const bf16x8*)ap; C.A1 = *(const bf16x8*)(ap + 16); }
#pragma unroll
        for (int j = 0; j < 2; ++j) { const v4u v = *(const v4u*)(projb + (size_t)(tq0 + 2 * hh + j) * NPROJ + C_IW);
            C.wq[j][0] = bflo(v.x); C.wq[j][1] = bfhi(v.x); C.wq[j][2] = bflo(v.y); C.wq[j][3] = bfhi(v.y); C.wq[j][4] = bflo(v.z); C.wq[j][5] = bfhi(v.z); C.wq[j][6] = bflo(v.w); C.wq[j][7] = bfhi(v.w); }
        C.tqj0 = tq0 + 2 * hh; C.tqj1 = C.tqj0 + 1; C.hh = hh; C.kl = kl;
        C.rd0 = kl * 64 + ((hh ^ ((kl >> 2) & 3)) * 16); C.rd1 = kl * 64 + (((hh + 2) ^ ((kl >> 2) & 3)) * 16);
        C.hist = hist; C.sel = sel; C.cand_u = cand_u; C.cand_i = cand_i; C.shift = 24; C.himask = 0u;
        const int ntile = (t0 >> 5) + 1, nchunk = (ntile + 7) >> 3, nkeys = ntile * 32, sstride = ntile >> 3;
        { const v4u z = {0u, 0u, 0u, 0u};
#pragma unroll
          for (int i = 0; i < 8; ++i) *(LAS v4u*)(hist + 4 * (lane + 64 * i)) = z; }
        if (tid == 0) flag[0] = 0u;
        S.prefix0 = 0u; S.prefix1 = 0u; S.need0 = TOPK; S.need1 = TOPK; S.eqt0 = 0u; S.eqt1 = 0u; S.cnt0 = 0u; S.cnt1 = 0u; S.cc0 = 0u; S.cc1 = 0u;
        S.rc0 = 0u; S.rc1 = 0u;
        C.rec_u = P.rec + (size_t)(F.bid * NWAVES + w) * (4 * RCAP * 6 / 4); C.rec_i = (unsigned short*)(C.rec_u + 4 * RCAP);
        S.blo0 = 0u; S.blo1 = 0u; S.inv0 = 0.f; S.inv1 = 0.f; S.c00 = 0.f; S.c01 = 0.f;
        idx_sweep<6>(C, S, ikbuf, ikb, tid, ntile, nchunk, nkeys, sstride);
        bool fast;
        {
            float sum0 = 0.f, sum1 = 0.f, sq0 = 0.f, sq1 = 0.f;
#pragma unroll
            for (int r = 0; r < 8; ++r) { sum0 += S.ss0[r]; sq0 = fmaf(S.ss0[r], S.ss0[r], sq0); sum1 += S.ss1[r]; sq1 = fmaf(S.ss1[r], S.ss1[r], sq1); }
#pragma unroll
            for (int o = 1; o < 32; o <<= 1) { sum0 += __shfl_xor(sum0, o); sq0 += __shfl_xor(sq0, o); sum1 += __shfl_xor(sum1, o); sq1 += __shfl_xor(sq1, o); }
            const float m0 = sum0 * (1.f / 256.f), m1 = sum1 * (1.f / 256.f);
            const float sd0 = sqrtf(fmaxf(sq0 * (1.f / 256.f) - m0 * m0, 0.f)), sd1 = sqrtf(fmaxf(sq1 * (1.f / 256.f) - m1 * m1, 0.f));
            const bool ok = (sd0 > 1e-30f) && (sd0 < 1e30f) && (sd1 > 1e-30f) && (sd1 < 1e30f);
            S.inv0 = 512.f / (11.f * sd0); S.inv1 = 512.f / (11.f * sd1);
            S.c00 = -(m0 - 5.f * sd0) * S.inv0; S.c01 = -(m1 - 5.f * sd1) * S.inv1;
            unsigned sb0[8], sb1[8];
#pragma unroll
            for (int r = 0; r < 8; ++r) { sb0[r] = lin_bin(S.ss0[r], S.inv0, S.c00); sb1[r] = lin_bin(S.ss1[r], S.inv1, S.c01); }
            const float ks0 = 65536.f / (float)(C.tqj0 + 1), ks1 = 65536.f / (float)(C.tqj1 + 1);
            const float kf0 = ks0 + 5.f * sqrtf(ks0) + 4.f, kf1 = ks1 + 5.f * sqrtf(ks1) + 4.f;
            const unsigned klo0 = kf0 >= 255.f ? 257u : (unsigned)kf0 + 1u, klo1 = kf1 >= 255.f ? 257u : (unsigned)kf1 + 1u;
            unsigned lo0 = 0u, hi0 = 512u, lo1 = 0u, hi1 = 512u;
#pragma unroll 1
            for (int step = 0; step < 9; ++step) {
                const unsigned mid0 = (lo0 + hi0) >> 1, mid1 = (lo1 + hi1) >> 1;
                unsigned n0 = 0u, n1 = 0u;
#pragma unroll
                for (int r = 0; r < 8; ++r) { n0 += (sb0[r] >= mid0) ? 1u : 0u; n1 += (sb1[r] >= mid1) ? 1u : 0u; }
#pragma unroll
                for (int o = 1; o < 32; o <<= 1) { n0 += (unsigned)__shfl_xor((int)n0, o); n1 += (unsigned)__shfl_xor((int)n1, o); }
                if (n0 >= klo0) lo0 = mid0; else hi0 = mid0;
                if (n1 >= klo1) lo1 = mid1; else hi1 = mid1;
            }
            S.blo0 = lo0; S.blo1 = lo1;
            if (__any(!ok) && lane == 0) __hip_atomic_fetch_or(flag, 1u, __ATOMIC_RELAXED, __HIP_MEMORY_SCOPE_WORKGROUP);
            LDS_WAIT();
            __syncthreads();
            fast = (flag[0] == 0u);
        }
        if (fast) {
            idx_sweep<9>(C, S, ikbuf, ikb, tid, ntile, nchunk, nkeys, sstride);
            LDS_WAIT();
            bool good = true;
#pragma unroll
            for (int qq = 0; qq < 4; ++qq) {
                int bin; unsigned above, binc;
                hist_scan512(hist + qq * 512, (unsigned)TOPK, lane, bin, above, binc);
                const unsigned tot = above + binc;
                if (hh == (qq >> 1)) { if (qq & 1) { S.prefix1 = (unsigned)bin; S.need1 = TOPK - above; } else { S.prefix0 = (unsigned)bin; S.need0 = TOPK - above; } }
                good = good && (binc <= (unsigned)CAND_CAP) && (tot >= (unsigned)TOPK);
            }
            good = good && !__any((S.rc0 > (unsigned)RCAP) || (S.rc1 > (unsigned)RCAP));
            { const v4u z = {0u, 0u, 0u, 0u};
#pragma unroll
              for (int i = 0; i < 8; ++i) *(LAS v4u*)(hist + 4 * (lane + 64 * i)) = z; }
            if (!good && lane == 0) __hip_atomic_fetch_or(flag, 1u, __ATOMIC_RELAXED, __HIP_MEMORY_SCOPE_WORKGROUP);
            VM_WAIT();
            LDS_WAIT();
            __syncthreads();
            fast = (flag[0] == 0u);
        }
        if (fast) {
#pragma unroll
            for (int qq = 0; qq < 4; ++qq) {
                const int own = (qq >> 1) * 32;
                const unsigned R = (unsigned)__shfl((int)((qq & 1) ? S.rc1 : S.rc0), own), bst = (unsigned)__shfl((int)((qq & 1) ? S.prefix1 : S.prefix0), own), nd = (unsigned)__shfl((int)((qq & 1) ? S.need1 : S.need0), own);
                const float inv = __shfl((qq & 1) ? S.inv1 : S.inv0, own), c0 = __shfl((qq & 1) ? S.c01 : S.c00, own);
                unsigned cq = 0u, cn = 0u;
#pragma unroll 1
                for (unsigned base = 0; base < R; base += 64) {
                    const unsigned i = base + lane; const bool in = i < R;
                    unsigned ub = 0u, ix = 0u;
                    if (in) { ub = __hip_atomic_load(C.rec_u + qq * RCAP + i, __ATOMIC_RELAXED, __HIP_MEMORY_SCOPE_AGENT); ix = __hip_atomic_load(C.rec_i + qq * RCAP + i, __ATOMIC_RELAXED, __HIP_MEMORY_SCOPE_AGENT); }
                    const float sv = __builtin_bit_cast(float, ub);
                    const unsigned bb = lin_bin(sv, inv, c0);
                    const bool gt = in && (bb > bst), eq = in && (bb == bst);
                    const unsigned long long mg = __ballot(gt), me = __ballot(eq);
                    const unsigned long long ltm = (1ull << lane) - 1ull;
                    const unsigned pos = cq + __popcll(mg & ltm); if (gt && pos < TOPK) sel[qq * 256 + pos] = (unsigned short)ix; cq += __popcll(mg);
                    const unsigned cp = cn + __popcll(me & ltm); if (eq && cp < (unsigned)CAND_CAP) { cand_u[qq * CAND_CAP + cp] = f2ord(sv); cand_i[qq * CAND_CAP + cp] = (unsigned short)ix; } cn += __popcll(me);
                }
                LDS_WAIT();
                const unsigned Cc = cn < (unsigned)CAND_CAP ? cn : (unsigned)CAND_CAP;
                unsigned cqq = cq;
#pragma unroll 1
                for (unsigned base = 0; base < Cc; base += 64) {
                    const unsigned i = base + lane;
                    const unsigned ui = cand_u[qq * CAND_CAP + (i & (CAND_CAP - 1))]; const unsigned ii = cand_i[qq * CAND_CAP + (i & (CAND_CAP - 1))];
                    unsigned rank = 0u;
#pragma unroll 1
                    for (unsigned j = 0; j < Cc; ++j) { const unsigned uj = cand_u[qq * CAND_CAP + j], ij = cand_i[qq * CAND_CAP + j]; rank += ((uj > ui) || (uj == ui && ij < ii)) ? 1u : 0u; }
                    const bool take = (i < Cc) && (rank < nd);
                    const unsigned long long mt = __ballot(take);
                    const unsigned pos = cqq + __popcll(mt & ((1ull << lane) - 1ull));
                    if (take && pos < TOPK) sel[qq * 256 + pos] = (unsigned short)ii;
                    cqq += __popcll(mt);
                }
            }
        } else {
            S.prefix0 = 0u; S.prefix1 = 0u; S.need0 = TOPK; S.need1 = TOPK; S.cnt0 = 0u; S.cnt1 = 0u; S.eqt0 = 0u; S.eqt1 = 0u;
#pragma unroll 1
            for (int pass = 0; pass < 4; ++pass) {
                C.shift = 24 - 8 * pass; C.himask = pass ? (0xFFFFFFFFu << (32 - 8 * pass)) : 0u;
                idx_sweep<0>(C, S, ikbuf, ikb, tid, ntile, nchunk, nkeys, sstride);
                LDS_WAIT();
#pragma unroll
                for (int qq = 0; qq < 4; ++qq) {
                    const unsigned nd = (unsigned)__shfl((int)((qq & 1) ? S.need1 : S.need0), (qq >> 1) * 32);
                    int bin; unsigned above, binc;
                    hist_scan(hist + qq * 256, nd, lane, bin, above, binc);
                    if (hh == (qq >> 1)) { if (qq & 1) { S.prefix1 |= (unsigned)bin << C.shift; S.need1 -= above; } else { S.prefix0 |= (unsigned)bin << C.shift; S.need0 -= above; } }
                    const v4u z = {0u, 0u, 0u, 0u}; *(LAS v4u*)(hist + qq * 256 + 4 * lane) = z;
                }
                LDS_WAIT();
            }
            idx_sweep<4>(C, S, ikbuf, ikb, tid, ntile, nchunk, nkeys, sstride);
        }
        LDS_WAIT();
    } else {
#pragma unroll
        for (int qq = 0; qq < 4; ++qq)
#pragma unroll
            for (int i = 0; i < 4; ++i) sel[qq * 256 + lane + 64 * i] = (unsigned short)(lane + 64 * i);
        LDS_WAIT();
    }

    int la_ = lane; asm volatile("" : "+v"(la_));
    const int n16 = la_ & 15, g = la_ >> 4;
#ifdef NO_ATT
    for (int qq = 0; qq < 0; ++qq) {
#else
    for (int repa = 0; repa < 1 + REP_ATT; ++repa)
#pragma unroll 1
    for (int qq = 0; qq < 4; ++qq) {
#endif
        const int tq = tq0 + qq; const int nsel = (tq + 1) < TOPK ? (tq + 1) : TOPK;
        { const v4u qa = *(const v4u*)(projb + (size_t)tq * NPROJ + C_QL + lane * 8), qb = *(const v4u*)(projb + (size_t)tq * NPROJ + C_QL + 512 + lane * 8);
          *(LAS v4u*)((LAS unsigned char*)obuf + lane * 16) = qa; *(LAS v4u*)((LAS unsigned char*)obuf + 1024 + lane * 16) = qb;
          if (lane < 16) *(LAS v4u*)((LAS unsigned char*)obuf + 2048 + lane * 16) = (v4u){0u, 0u, 0u, 0u}; }
        const int qoff = (n16 < 8 ? n16 * 256 : 2048) + 16 * g;
        LDS_WAIT();
        float m_run = -INFINITY, lsum = 0.f;
        f32x4 O[8];
#pragma unroll
        for (int ct = 0; ct < 8; ++ct) O[ct] = (f32x4){0.f, 0.f, 0.f, 0.f};
        const int nch = (nsel + 31) >> 5;
        v4u gvA[8], gvB[8]; f32x4 pqA = {0.f, 0.f, 0.f, 0.f}, pqB = pqA;
#define ATT_LOAD(GV, PQ, cc) do { \
            _Pragma("unroll") for (int it = 0; it < 8; ++it) { const int si = 32 * (cc) + g + 4 * it; const int ki = (si < nsel) ? (int)sel[qq * 256 + si] : 0; GV[it] = *(const v4u*)(ckvb + (size_t)ki * 128 + n16 * 8); } \
            if (lane < 32) { const int si = 32 * (cc) + lane; const int ki = (si < nsel) ? (int)sel[qq * 256 + si] : 0; PQ = *(const f32x4*)(ssqb + (size_t)ki * 4); } } while (0)
#define ATT_CHUNK(GV, PQ, c) do { \
            _Pragma("unroll") for (int it = 0; it < 8; ++it) { const int i = g + 4 * it; *(LAS v4u*)(cbuf + 256 * i + 16 * (n16 ^ swz16(i))) = GV[it]; } \
            if (lane < 32) rsbuf[lane] = 1.0f / sqrtf(((PQ[0] + PQ[1]) + (PQ[2] + PQ[3])) * (1.f / 128.f) + LN_EPS); \
            LDS_WAIT(); \
            if ((c) + 2 < nch) ATT_LOAD(GV, PQ, (c) + 2); \
            f32x4 sc[2]; \
            { bf16x8 bq[4]; \
              _Pragma("unroll") for (int ks = 0; ks < 4; ++ks) bq[ks] = *(LAS bf16x8*)((LAS unsigned char*)obuf + qoff + 64 * ks); \
              _Pragma("unroll") for (int tt = 0; tt < 2; ++tt) { \
                f32x4 a = {0.f, 0.f, 0.f, 0.f}; const int row = 16 * tt + n16; \
                _Pragma("unroll") for (int ks = 0; ks < 4; ++ks) { \
                    const bf16x8 af = *(LAS bf16x8*)(cbuf + 256 * row + 16 * ((4 * ks + g) ^ swz16(row))); \
                    a = __builtin_amdgcn_mfma_f32_16x16x32_bf16(af, bq[ks], a, 0, 0, 0); } \
                sc[tt] = a; __builtin_amdgcn_sched_barrier(0); } } \
            f32x4 rsv[2]; rsv[0] = *(LAS f32x4*)(rsbuf + 4 * g); rsv[1] = *(LAS f32x4*)(rsbuf + 16 + 4 * g); \
            float cmax = -INFINITY; \
            _Pragma("unroll") for (int tt = 0; tt < 2; ++tt) _Pragma("unroll") for (int r = 0; r < 4; ++r) { float s = sc[tt][r] * rsv[tt][r]; if (32 * (c) + 16 * tt + 4 * g + r >= nsel) s = -INFINITY; sc[tt][r] = s; cmax = fmaxf(cmax, s); } \
            cmax = fmaxf(cmax, __shfl_xor(cmax, 16)); cmax = fmaxf(cmax, __shfl_xor(cmax, 32)); \
            const float mnew = fmaxf(m_run, cmax); const float alpha = __expf(m_run - mnew); \
            float psum = 0.f; float pp[2][4]; \
            _Pragma("unroll") for (int tt = 0; tt < 2; ++tt) _Pragma("unroll") for (int r = 0; r < 4; ++r) { const float p = __expf(sc[tt][r] - mnew); psum += p; pp[tt][r] = p * rsv[tt][r]; } \
            lsum = lsum * alpha + psum; m_run = mnew; \
            bf16x8 PA; { v4u pw; pw.x = pk2(pp[0][0], pp[0][1]); pw.y = pk2(pp[0][2], pp[0][3]); pw.z = pk2(pp[1][0], pp[1][1]); pw.w = pk2(pp[1][2], pp[1][3]); PA = __builtin_bit_cast(bf16x8, pw); } \
            float ar[4]; _Pragma("unroll") for (int r = 0; r < 4; ++r) ar[r] = __shfl(alpha, 4 * g + r); \
            _Pragma("unroll") for (int ct = 0; ct < 8; ++ct) { O[ct][0] *= ar[0]; O[ct][1] *= ar[1]; O[ct][2] *= ar[2]; O[ct][3] *= ar[3]; } \
            { const int qrow = (n16 >> 2), p4 = n16 & 3; const int rlo = 4 * g + qrow, rhi = 16 + 4 * g + qrow; \
              _Pragma("unroll") for (int ct = 0; ct < 8; ++ct) { const int ch = 2 * ct + (p4 >> 1); \
                  const s16x4 lo = __builtin_bit_cast(s16x4, __builtin_amdgcn_ds_read_tr16_b64_v4i16((LAS s16x4*)(cbuf + 256 * rlo + 16 * (ch ^ swz16(rlo)) + 8 * (p4 & 1)))); \
                  const s16x4 hi = __builtin_bit_cast(s16x4, __builtin_amdgcn_ds_read_tr16_b64_v4i16((LAS s16x4*)(cbuf + 256 * rhi + 16 * (ch ^ swz16(rhi)) + 8 * (p4 & 1)))); \
                  const bf16x8 vf = {lo[0], lo[1], lo[2], lo[3], hi[0], hi[1], hi[2], hi[3]}; \
                  O[ct] = __builtin_amdgcn_mfma_f32_16x16x32_bf16(PA, vf, O[ct], 0, 0, 0); if ((ct & 1) == 1) __builtin_amdgcn_sched_barrier(0); } } \
            LDS_WAIT(); asm volatile("" ::: "memory"); } while (0)
        ATT_LOAD(gvA, pqA, 0);
        if (nch > 1) ATT_LOAD(gvB, pqB, 1);
#pragma unroll 1
        for (int c = 0; c < nch; c += 2) {
            ATT_CHUNK(gvA, pqA, c);
            if (c + 1 < nch) ATT_CHUNK(gvB, pqB, c + 1);
        }
#undef ATT_LOAD
#undef ATT_CHUNK
        float ltot = lsum; ltot += __shfl_xor(ltot, 16); ltot += __shfl_xor(ltot, 32);
        const float inv = 1.0f / ltot;
        float ir[4];
#pragma unroll
        for (int r = 0; r < 4; ++r) ir[r] = __shfl(inv, 4 * g + r);
        if (g < 2) {
#pragma unroll
            for (int ct = 0; ct < 8; ++ct)
#pragma unroll
                for (int r = 0; r < 4; ++r) obuf[(4 * g + r) * 128 + 16 * ct + n16] = (bf16_t)f2bf(O[ct][r] * ir[r]);
        }
        LDS_WAIT();
        { bf16_t* dst = P.ymix + (size_t)(b * SEQ + tq) * KMIX;
#pragma unroll
          for (int k = 0; k < 2; ++k) { const int piece = lane + 64 * k; *(v4u*)(dst + piece * 8) = *(LAS v4u*)((LAS unsigned char*)obuf + piece * 16); } }
        LDS_WAIT();
        asm volatile("" ::: "memory");
    }
    __syncthreads();
}

#ifndef REP_CP
#define REP_CP 0
#endif
#ifndef REP_DSA
#define REP_DSA 0
#endif
__device__ __forceinline__ void phase_mixers(const Frame& F0, int l) {
    const Frame F = relaunder(F0);
    KArgs A = kargs();
    MixP P;
    P.rec = (unsigned*)(A->ws + WS_REC); P.proj = ws_bf(A, WS_PROJ); P.ikc = ws_bf(A, WS_IKC); P.ckvc = ws_bf(A, WS_CKVC); P.ymix = ws_bf(A, WS_YMIX); P.ssq = (const float*)(A->ws + WS_SSQ);
    P.wpt = ws_bf(A, WS_WPT); P.pool_scale = A->in[6] + l * 256; P.conv_w = A->in[7] + (size_t)l * 31 * 256; P.conv_b = A->in[8] + l * 256;
    P.cln_g = A->in[9] + l * 256; P.cln_b = A->in[10] + l * 256;
#ifndef NO_CONVPOOL
#pragma unroll 1
    for (int rep = 0; rep < 1 + REP_CP; ++rep)
#pragma unroll 1
    for (int tile = F.bid; tile < M / 32; tile += F.G) conv_pool_tile(F, P, tile);
#endif
    __syncthreads();
#pragma unroll 1
    for (int rep = 0; rep < 1 + REP_DSA; ++rep)
#pragma unroll 1
    for (int it = F.bid; it < 512; it += F.G) {
        const int b = it >> 8, gi = it & 255; const int grp = b ? (255 - gi) : gi;
#ifndef NO_DSA
        dsa_group(F, P, b, grp * 32);
#endif
    }
    __syncthreads();
}

__device__ __forceinline__ float top2sum4(float a, float b, float c, float d) {
    const float hi1 = fmaxf(a, b), lo1 = fminf(a, b), hi2 = fmaxf(c, d), lo2 = fminf(c, d);
    const float top = fmaxf(hi1, hi2), second = fmaxf(fminf(hi1, hi2), (hi1 >= hi2) ? lo1 : lo2);
    return top + second;
}
__device__ __forceinline__ void phase_ln1_router(const Frame& F0, int l) {
    const Frame F = relaunder(F0);
    KArgs A = kargs();
    float* out = A->out; bf16_t* xb = ws_bf(A, WS_XB);
    const float* ln1_g = A->in[12] + l * DM; const float* ln1_b = A->in[13] + l * DM; const float* router_w = A->in[14]; const float* router_b = A->in[15];
    int* toke = (int*)(A->ws + WS_TOKE); float* tokg = (float*)(A->ws + WS_TOKG); unsigned* blkcnt = (unsigned*)(A->ws + WS_BLKCNT);
    const int lane = F.lane, wave = F.wave;
    LAS float* xs = (LAS float*)(F.lds + wave * 4096);
    LAS unsigned* cnt = (LAS unsigned*)(F.lds + LDS_MISC + 512);
    if (F.tid < 16) cnt[F.tid] = 0u;
    __syncthreads();
    const int e16 = lane & 15, qr = lane >> 4;
    const float bias_e = router_b[e16];
#pragma unroll 1
    for (int i = 0; i < 8; ++i) {
        const int row = F.bid * 64 + wave * 8 + i;
        float* vr = out + (size_t)row * DM;
        f32x4 v[4]; float s = 0.f;
#pragma unroll
        for (int j = 0; j < 4; ++j) { v[j] = *(const f32x4*)(vr + 4 * lane + 256 * j); s += (v[j][0] + v[j][1]) + (v[j][2] + v[j][3]); }
        const float mean = wave_sum(s) * (1.f / DM); float s2 = 0.f;
#pragma unroll
        for (int j = 0; j < 4; ++j) { v[j] = v[j] - mean; s2 += (v[j][0] * v[j][0] + v[j][1] * v[j][1]) + (v[j][2] * v[j][2] + v[j][3] * v[j][3]); }
        const float rstd = 1.0f / sqrtf(wave_sum(s2) * (1.f / DM) + LN_EPS);
#pragma unroll
        for (int j = 0; j < 4; ++j) {
            const f32x4 g = *(const f32x4*)(ln1_g + 4 * lane + 256 * j), b = *(const f32x4*)(ln1_b + 4 * lane + 256 * j);
            const f32x4 y = v[j] * rstd * g + b;
            *(f32x4*)(vr + 4 * lane + 256 * j) = y;
            v2u w; w.x = pk2(y[0], y[1]); w.y = pk2(y[2], y[3]); *(v2u*)(xb + (size_t)row * DM + 4 * lane + 256 * j) = w;
            *(LAS f32x4*)(xs + 4 * lane + 256 * j) = y;
        }
        LDS_WAIT();
        float acc = 0.f;
        { const float* rw = router_w + (size_t)(qr * 256) * NE + e16; const LAS float* xq = xs + qr * 256;
#pragma unroll 8
          for (int c = 0; c < 256; ++c) acc += xq[c] * rw[c * NE]; }
        acc += __shfl_xor(acc, 16); acc += __shfl_xor(acc, 32);
        const float aff = sigmoidf_(acc), scv = aff + bias_e;
        float sv[16];
#pragma unroll
        for (int k = 0; k < 16; ++k) sv[k] = __shfl(scv, k);
        float gs[4];
#pragma unroll
        for (int gq = 0; gq < 4; ++gq) gs[gq] = top2sum4(sv[4 * gq], sv[4 * gq + 1], sv[4 * gq + 2], sv[4 * gq + 3]);
        int best = 0; float bv = gs[0];
#pragma unroll
        for (int gq = 1; gq < 4; ++gq) if (gs[gq] > bv) { bv = gs[gq]; best = gq; }
        float c0 = sv[0], c1 = sv[1], c2 = sv[2], c3 = sv[3];
#pragma unroll
        for (int gq = 1; gq < 4; ++gq) if (best == gq) { c0 = sv[4 * gq]; c1 = sv[4 * gq + 1]; c2 = sv[4 * gq + 2]; c3 = sv[4 * gq + 3]; }
        int i1 = 0; float m1 = c0;
        if (c1 > m1) { m1 = c1; i1 = 1; } if (c2 > m1) { m1 = c2; i1 = 2; } if (c3 > m1) { m1 = c3; i1 = 3; }
        int i2 = -1; float m2 = -INFINITY;
        if (i1 != 0 && c0 > m2) { m2 = c0; i2 = 0; } if (i1 != 1 && c1 > m2) { m2 = c1; i2 = 1; } if (i1 != 2 && c2 > m2) { m2 = c2; i2 = 2; } if (i1 != 3 && c3 > m2) { m2 = c3; i2 = 3; }
        if (i2 < 0) i2 = (i1 == 0) ? 1 : 0;
        const int e1 = 4 * best + i1, e2 = 4 * best + i2;
        const float a1 = __shfl(aff, e1), a2 = __shfl(aff, e2);
        const float den = a1 + a2;
        if (lane == 0) {
            toke[row * 2] = e1; toke[row * 2 + 1] = e2; tokg[row * 2] = a1 / den; tokg[row * 2 + 1] = a2 / den;
            __hip_atomic_fetch_add(cnt + e1, 1u, __ATOMIC_RELAXED, __HIP_MEMORY_SCOPE_WORKGROUP);
            __hip_atomic_fetch_add(cnt + e2, 1u, __ATOMIC_RELAXED, __HIP_MEMORY_SCOPE_WORKGROUP);
        }
        LDS_WAIT();
    }
    __syncthreads();
    if (F.tid < 16) blkcnt[F.bid * 16 + F.tid] = cnt[F.tid];
}

__device__ __forceinline__ void phase_route(const Frame& F0) {
    const Frame F = relaunder(F0);
    KArgs A = kargs();
    const bf16_t* xb = ws_bf(A, WS_XB); bf16_t* xs = ws_bf(A, WS_XS);
    const int* toke = (const int*)(A->ws + WS_TOKE); const float* tokg = (const float*)(A->ws + WS_TOKG); int* toks = (int*)(A->ws + WS_TOKS);
    float* gslot = (float*)(A->ws + WS_GSLOT); int* tiletab = (int*)(A->ws + WS_TILETAB); const unsigned* blkcnt = (const unsigned*)(A->ws + WS_BLKCNT);
    const int lane = F.lane, wave = F.wave;
    LAS int* slots = (LAS int*)(F.lds + LDS_MISC + 1024);
    if (wave == 0) {
        const int e = lane & 15, part = lane >> 4;
        unsigned tot = 0u, pre = 0u;
#pragma unroll 16
        for (int bb = part; bb < F.G; bb += 4) { const unsigned c = blkcnt[bb * 16 + e]; tot += c; if (bb < F.bid) pre += c; }
        tot += __shfl_xor((int)tot, 16); tot += __shfl_xor((int)tot, 32);
        pre += __shfl_xor((int)pre, 16); pre += __shfl_xor((int)pre, 32);
        const unsigned padded = (tot + 255u) & ~255u;
        unsigned off = 0u, total_pad = 0u;
#pragma unroll
        for (int k = 0; k < 16; ++k) { const unsigned pk = (unsigned)__shfl((int)padded, k); if (k < e) off += pk; total_pad += pk; }
        unsigned base = off + pre;
        const int myrow = F.bid * 64 + lane;
        const int me1 = ld_agent(toke + myrow * 2), me2 = ld_agent(toke + myrow * 2 + 1);
        const float mg1 = ld_agent_f(tokg + myrow * 2), mg2 = ld_agent_f(tokg + myrow * 2 + 1);
        unsigned ms1 = 0u, ms2 = 0u;
#pragma unroll 1
        for (int i = 0; i < 64; ++i) {
            const int e1 = __shfl(me1, i), e2 = __shfl(me2, i);
            const unsigned s1 = (unsigned)__shfl((int)base, e1); base += (e == e1) ? 1u : 0u;
            const unsigned s2 = (unsigned)__shfl((int)base, e2); base += (e == e2) ? 1u : 0u;
            if (lane == i) { ms1 = s1; ms2 = s2; }
        }
        slots[2 * lane] = (int)ms1; slots[2 * lane + 1] = (int)ms2; toks[myrow * 2] = (int)ms1; toks[myrow * 2 + 1] = (int)ms2;
        gslot[ms1] = mg1; gslot[ms2] = mg2;
        if (F.bid == 0) {
            const int ntile = (int)(total_pad >> 8);
            if (lane == 0) tiletab[0] = ntile;
            for (int t = lane; t < ntile; t += 64) {
                int ex = 0;
#pragma unroll
                for (int k = 0; k < 16; ++k) { const unsigned ok = (unsigned)__shfl((int)off, k); if ((unsigned)(t * 256) >= ok) ex = k; }
                tiletab[1 + t] = ex;
            }
#pragma unroll
            for (int k = 0; k < 16; ++k) {
                const unsigned ok = (unsigned)__shfl((int)off, k), tk = (unsigned)__shfl((int)tot, k), pk = (unsigned)__shfl((int)padded, k);
                for (unsigned s = ok + tk + lane; s < ok + pk; s += 64) gslot[s] = 0.f;
            }
        }
    }
    LDS_WAIT();
    __syncthreads();
#pragma unroll 1
    for (int i = 0; i < 8; ++i) {
        const int ti = wave * 8 + i, row = F.bid * 64 + ti;
        const v4u a = *(const v4u*)(xb + (size_t)row * DM + lane * 8), b = *(const v4u*)(xb + (size_t)row * DM + 512 + lane * 8);
#pragma unroll
        for (int k = 0; k < 2; ++k) { const int s = slots[2 * ti + k]; bf16_t* d = xs + (size_t)s * DM; *(v4u*)(d + lane * 8) = a; *(v4u*)(d + 512 + lane * 8) = b; }
    }
}

__device__ __forceinline__ void phase_ln2(const Frame& F0, int l) {
    const Frame F = relaunder(F0);
    KArgs A = kargs();
    float* out = A->out; bf16_t* xb = ws_bf(A, WS_XB); const int* toks = (const int*)(A->ws + WS_TOKS);
    const float* ln2_g = A->in[19] + l * DM; const float* ln2_b = A->in[20] + l * DM;
    const int lane = F.lane, wave = F.wave;
    const bf16_t* Y = ws_bf(A, WS_XS);
#pragma unroll 1
    for (int i = 0; i < 8; ++i) {
        const int row = F.bid * 64 + wave * 8 + i;
        const int s0 = ld_agent(toks + row * 2), s1 = ld_agent(toks + row * 2 + 1);
        float* vr = out + (size_t)row * DM;
        f32x4 v[4]; float s = 0.f;
#pragma unroll
        for (int j = 0; j < 4; ++j) {
            const f32x4 x = *(const f32x4*)(vr + 4 * lane + 256 * j);
            const v2u y0 = *(const v2u*)(Y + (size_t)s0 * DM + 4 * lane + 256 * j), y1 = *(const v2u*)(Y + (size_t)s1 * DM + 4 * lane + 256 * j);
            f32x4 f; f[0] = bflo(y0.x) + bflo(y1.x); f[1] = bfhi(y0.x) + bfhi(y1.x); f[2] = bflo(y0.y) + bflo(y1.y); f[3] = bfhi(y0.y) + bfhi(y1.y);
            v[j] = x * ALPHA + f; s += (v[j][0] + v[j][1]) + (v[j][2] + v[j][3]);
        }
        const float mean = wave_sum(s) * (1.f / DM); float s2 = 0.f;
#pragma unroll
        for (int j = 0; j < 4; ++j) { v[j] = v[j] - mean; s2 += (v[j][0] * v[j][0] + v[j][1] * v[j][1]) + (v[j][2] * v[j][2] + v[j][3] * v[j][3]); }
        const float rstd = 1.0f / sqrtf(wave_sum(s2) * (1.f / DM) + LN_EPS);
#pragma unroll
        for (int j = 0; j < 4; ++j) {
            const f32x4 g = *(const f32x4*)(ln2_g + 4 * lane + 256 * j), b = *(const f32x4*)(ln2_b + 4 * lane + 256 * j);
            const f32x4 y = v[j] * rstd * g + b;
            *(f32x4*)(vr + 4 * lane + 256 * j) = y;
            v2u w; w.x = pk2(y[0], y[1]); w.y = pk2(y[2], y[3]); *(v2u*)(xb + (size_t)row * DM + 4 * lane + 256 * j) = w;
        }
    }
}

constexpr int N_PHASES = 17;

__global__ void __launch_bounds__(NTHR, 2) fwd_kernel(Args args) {
    extern __shared__ __attribute__((aligned(16))) unsigned char lds_raw[];
    cg::grid_group grid = cg::this_grid();
    Frame F;
    F.lds = (LAS unsigned char*)lds_raw;
    F.tid = threadIdx.x; F.lane = F.tid & 63; F.wave = __builtin_amdgcn_readfirstlane(F.tid >> 6);
    F.G = gridDim.x; F.bid = blockIdx.x;
    const int lo = args.ph_lo, hi = args.ph_hi, coop = args.coop;
    if (F.tid < 32) ((LAS unsigned*)(F.lds + LDS_MISC))[F.tid] = 0u;
    __syncthreads();
    XcdBarrier bar; bar.bar = nullptr; bar.x = 0; bar.st = nullptr;
    if (coop) bar = xcd_barrier_post((unsigned*)(kargs()->ws + WS_BAR), (volatile LAS unsigned*)(F.lds + LDS_MISC) + 8);
#ifndef PHMASK
#define PHMASK 0x1ff
#endif
#define IN(k) (lo <= (k) && (k) < hi)
#define EN(b) ((PHMASK >> (b)) & 1)
#ifndef REPMASK
#define REPMASK 0
#endif
#define NREP(b) (1 + ((REPMASK >> (b)) & 1))
#define SEAM(k) do { if (IN(k) && IN((k) + 1)) { if (coop) { if ((k) == 0) grid.sync(); else xcd_barrier(bar); } } } while (0)

    if (EN(0) && IN(0)) for (int rep = 0; rep < NREP(0); ++rep) { if (rep) xcd_barrier(bar); phase_convert(F, 0, true, 0); }
    SEAM(0);
#pragma unroll 1
    for (int l = 0; l < 2; ++l) {
        const int pb = 1 + 8 * l;
        if (EN(1) && IN(pb + 0)) for (int rep = 0; rep < NREP(1); ++rep) {
            if (rep) xcd_barrier(bar);
            KArgs A = kargs();
            pg8::Gemm g{ws_bf(A, WS_XB), ws_bf(A, WS_WIN), M, NPROJ, DM}; pg8::StaticOrder S; S.init(M, NPROJ, F.G, F.bid);
            EpiProj E{ws_bf(A, WS_PROJ), (float*)(A->ws + WS_SSQ), ws_bf(A, WS_IKC), ws_bf(A, WS_CKVC)};
            pg8::gemm_phase<EpiProj, pg8::StaticOrder, true, true>(F.lds, g, S, E);
        }
        SEAM(pb + 0);
        if (EN(2) && IN(pb + 1)) for (int rep = 0; rep < NREP(2); ++rep) { if (rep) xcd_barrier(bar); phase_mixers(F, l); }
        SEAM(pb + 1);
        if (EN(3) && IN(pb + 2)) {
            KArgs A = kargs();
            pg8::Gemm g{ws_bf(A, WS_YMIX), ws_bf(A, WS_WO), M, DM, KMIX}; pg8::StaticOrder S; S.init(M, DM, F.G, F.bid);
            EpiMix E{l == 0 ? A->in[0] : (const float*)A->out, A->out};
            pg8::gemm_phase<EpiMix, pg8::StaticOrder, true, true>(F.lds, g, S, E);
        }
        SEAM(pb + 2);
        if (EN(4) && IN(pb + 3)) { phase_ln1_router(F, l); __syncthreads(); phase_convert(F, l, false, 1); }
        SEAM(pb + 3);
        if (EN(5) && IN(pb + 4)) for (int rep = 0; rep < NREP(5); ++rep) { if (rep) xcd_barrier(bar); phase_route(F); }
        SEAM(pb + 4);
        if (EN(6) && IN(pb + 5)) for (int rep = 0; rep < NREP(6); ++rep) {
            if (rep) xcd_barrier(bar);
            KArgs A = kargs();
            pg8::Gemm g{ws_bf(A, WS_XS), ws_bf(A, WS_WGU), MAXSLOT, NE * 1024, DM}; GroupedOrder S; S.init((const int*)(A->ws + WS_TILETAB), F.G, F.bid);
            EpiGU E{ws_bf(A, WS_H), (const float*)(A->ws + WS_GSLOT)};
            pg8::gemm_phase<EpiGU, GroupedOrder, true, true>(F.lds, g, S, E);
        }
        SEAM(pb + 5);
        if (EN(7) && IN(pb + 6)) for (int rep = 0; rep < NREP(7); ++rep) {
            if (rep) xcd_barrier(bar);
            KArgs A = kargs();
            pg8::Gemm g{ws_bf(A, WS_H), ws_bf(A, WS_WD), MAXSLOT, NE * 1024, DE}; GroupedOrder S; S.init((const int*)(A->ws + WS_TILETAB), F.G, F.bid);
            EpiDown E{ws_bf(A, WS_XS)};
            pg8::gemm_phase<EpiDown, GroupedOrder, true, true>(F.lds, g, S, E);
        }
        SEAM(pb + 6);
        if (EN(8) && IN(pb + 7)) {
            phase_ln2(F, l);
            if (l == 0) { __syncthreads(); phase_convert(F, 1, false, 0); }
        }
        if (l == 0) SEAM(pb + 7);
    }
#undef IN
#undef SEAM
}

#ifndef MK_N_LAUNCHES
#define MK_N_LAUNCHES 1
#endif

extern "C" void kernel_launch(void* const* d_in, const int* in_sizes, int n_in, void* d_out, int out_size, void* d_ws, size_t ws_size, hipStream_t stream) {
    static int grid = 0;
    if (grid == 0) {
        int dev = 0, cus = 0, per_cu = 0;
        if (n_in != 21 || out_size != M * DM || ws_size < WS_END) { fprintf(stderr, "kernel_launch: unexpected problem (n_in %d out %d ws %zu)\n", n_in, out_size, ws_size); grid = -1; return; }
        if (hipGetDevice(&dev) != hipSuccess || hipDeviceGetAttribute(&cus, hipDeviceAttributeMultiprocessorCount, dev) != hipSuccess) { grid = -1; return; }
        if (hipFuncSetAttribute((const void*)fwd_kernel, hipFuncAttributeMaxDynamicSharedMemorySize, LDS_BYTES) != hipSuccess) { fprintf(stderr, "kernel_launch: hipFuncSetAttribute failed\n"); grid = -1; return; }
        if (hipOccupancyMaxActiveBlocksPerMultiprocessor(&per_cu, (const void*)fwd_kernel, NTHR, LDS_BYTES) != hipSuccess || per_cu < 1) { fprintf(stderr, "kernel_launch: occupancy query says %d\n", per_cu); grid = -1; (void)hipGetLastError(); return; }
        grid = cus;
        if (grid != 256) { fprintf(stderr, "kernel_launch: built for 256 CUs, found %d\n", cus); grid = -1; return; }
    }
    if (grid < 0) return;
    if (hipMemsetAsync((char*)d_ws + WS_BAR, 0, 16384, stream) != hipSuccess) { fprintf(stderr, "kernel_launch: memset failed\n"); return; }
    Args a{};
    for (int i = 0; i < 21; ++i) a.in[i] = (const float*)d_in[i];
    a.out = (float*)d_out; a.ws = (unsigned char*)d_ws; a.pad = 0;
#if MK_N_LAUNCHES == 1
    a.ph_lo = 0; a.ph_hi = N_PHASES; a.coop = 1;
    void* kargs[] = {&a};
    hipError_t e = hipLaunchCooperativeKernel((const void*)fwd_kernel, dim3(grid), dim3(NTHR), kargs, LDS_BYTES, stream);
    if (e != hipSuccess) fprintf(stderr, "kernel_launch: cooperative launch failed: %s\n", hipGetErrorString(e));
#else
    for (int p = 0; p < N_PHASES; ++p) {
        a.ph_lo = p; a.ph_hi = p + 1; a.coop = 0;
        hipLaunchKernelGGL(fwd_kernel, dim3(grid), dim3(NTHR), LDS_BYTES, stream, a);
    }
#endif
}
```

```cpp
#include <hip/hip_runtime.h>
#include <hip/hip_cooperative_groups.h>
#include <cstdio>
#include <cstdint>
namespace cg = cooperative_groups;
namespace pg8 {
#define PG8_LAS __attribute__((address_space(3)))
typedef unsigned short bf16_t;
typedef short bf16x8 __attribute__((ext_vector_type(8)));
typedef float f32x4 __attribute__((ext_vector_type(4)));
typedef unsigned u32x4 __attribute__((ext_vector_type(4)));
constexpr int BM = 256, BK = 64, HALF = 128, HTB = HALF * BK * 2  , STAGE_BYTES = 8 * HTB, NXCD = 8, WGM = 8;

__host__ __device__ __forceinline__ int lds_byte(int r, int c) { const int st = (r >> 4) * 2 + (c >> 5), rr = r & 15, cc = c & 31, ob = rr * 64 + cc * 2; return st * 1024 + (ob ^ (((ob >> 9) & 1) << 5)); }
__host__ __device__ __forceinline__ void stage_rc(int b, int& R, int& C) { const int st = b / 1024, sb = b % 1024, swz = sb ^ (((sb >> 9) & 1) << 5); R = (st >> 1) * 16 + swz / 64; C = (st & 1) * 32 + (swz % 64) / 2; }
__host__ __device__ __forceinline__ int perm32(int rho) { const int n = rho >> 4, i = rho & 15; return 8 * (i >> 2) + 4 * n + (i & 3); }

struct Unit { int pm, pn; };
struct Gemm { const bf16_t* A; const bf16_t* Bt; int M, N, K; };

struct StaticOrder {
    int nM, nN, nwg, G, c;
    __host__ __device__ void init(int M, int N, int G_, int c_) { nM = M / BM; nN = N / BM; nwg = nM * nN; G = G_; c = c_; }
    __host__ __device__ bool next(int i, Unit& u) const {
        const long L = (long)i * G + c; if (L >= nwg) return false;
        int wgid = (int)L; { const int q = nwg / NXCD, r = nwg % NXCD, xcd = wgid % NXCD, off = wgid / NXCD; wgid = (xcd < r ? xcd * (q + 1) : r * (q + 1) + (xcd - r) * q) + off; }
        const int nig = WGM * nN, gid = wgid / nig, fm = gid * WGM, gsz = (nM - fm) < WGM ? (nM - fm) : WGM;
        u.pm = fm + ((wgid % nig) % gsz); u.pn = (wgid % nig) / gsz; return true;
    }
    __device__ __forceinline__ void a_ready(const Unit&) const {}
    __device__ __forceinline__ void done(const Unit&) const {}
};

template <class Epi, class Sched, bool ALIGN_EPI = false, bool SP2 = false>
__device__ __forceinline__ void gemm_phase(PG8_LAS unsigned char* lds, const Gemm g, const Sched& S, const Epi& E) {
    int tid_ = threadIdx.x; asm volatile("" : "+v"(tid_));
    const int tid = tid_, wid = __builtin_amdgcn_readfirstlane(tid >> 6), lane = tid & 63, wr = wid >> 2, wc = wid & 3, fr = lane & 15, fq = lane >> 4;
    const int K = g.K, nt = K / BK;
    unsigned voffA[2], voffB[2];
#pragma unroll
    for (int i = 0; i < 2; ++i) { int R, C; stage_rc(tid * 16 + i * 8192, R, C); const int Rb = Epi::PERM ? ((R & ~31) + perm32(R & 31)) : R;
        voffA[i] = (unsigned)(R * K + C) * 2u; voffB[i] = (unsigned)(Rb * K + C) * 2u; }
    const size_t kstep = (size_t)(BK * 2);
    const size_t hstep = (size_t)HALF * K * 2;
    const size_t tstep = 2 * hstep;
    const unsigned ldsw = (unsigned)wid * 1024u;
    const int aoff = lds_byte(wr * 64 + fr, fq * 8), boff = lds_byte(wc * 32 + fr, fq * 8);
#define PG8_SA(b, h) (((b) * 2 + (h)) * HTB)
#define PG8_SB(b, h) ((4 + (b) * 2 + (h)) * HTB)
#define PG8_STAGE(bufoff, gbase, voff) do { _Pragma("unroll") for (int _i = 0; _i < 2; ++_i) \
        __builtin_amdgcn_global_load_lds((const unsigned*)((const char*)(gbase) + (voff)[_i]), (PG8_LAS unsigned*)(lds + (bufoff) + ldsw + _i * 8192), 16, 0, 0); } while (0)
#define PG8_LDA(dst, b, h) do { _Pragma("unroll") for (int m = 0; m < 4; ++m) _Pragma("unroll") for (int k = 0; k < 2; ++k) dst[m][k] = *(const PG8_LAS bf16x8*)(lds + PG8_SA(b, h) + aoff + m * 2048 + k * 1024); } while (0)
#define PG8_LDB(dst, b, h) do { _Pragma("unroll") for (int n = 0; n < 2; ++n) _Pragma("unroll") for (int k = 0; k < 2; ++k) dst[n][k] = *(const PG8_LAS bf16x8*)(lds + PG8_SB(b, h) + boff + n * 2048 + k * 1024); } while (0)
#define PG8_MMA(ai, bj, At, Bt) do { __builtin_amdgcn_s_setprio(1); _Pragma("unroll") for (int m = 0; m < 4; ++m) _Pragma("unroll") for (int n = 0; n < 2; ++n) _Pragma("unroll") for (int k = 0; k < 2; ++k) \
        acc[ai][bj][m][n] = __builtin_amdgcn_mfma_f32_16x16x32_bf16(Bt[n][k], At[m][k], acc[ai][bj][m][n], 0, 0, 0); __builtin_amdgcn_s_setprio(0); } while (0)
#define PG8_WAIT_V(n) asm volatile("s_waitcnt vmcnt(" #n ")" ::: "memory")
#define PG8_WAIT_L(n) asm volatile("s_waitcnt lgkmcnt(" #n ")" ::: "memory")
#define PG8_BAR __builtin_amdgcn_s_barrier()
#define PG8_SCHED __builtin_amdgcn_sched_barrier(0)
    Unit cur, nxt; int ui = 0;
    if (!S.next(0, cur)) return;
    f32x4 acc[2][2][4][2];
#pragma unroll
    for (int a = 0; a < 2; ++a)
#pragma unroll
        for (int b = 0; b < 2; ++b)
#pragma unroll
            for (int m = 0; m < 4; ++m)
#pragma unroll
                for (int n = 0; n < 2; ++n) acc[a][b][m][n] = (f32x4){0.f, 0.f, 0.f, 0.f};
    bf16x8 At[4][2], B0[2][2], B1[2][2];
    const char* cA = (const char*)g.A + (size_t)cur.pm * tstep; const char* cB = (const char*)g.Bt + (size_t)cur.pn * tstep;
    S.a_ready(cur);
    if constexpr (SP2) {
        PG8_STAGE(PG8_SB(0, 0), cB, voffB); PG8_STAGE(PG8_SB(0, 1), cB + hstep, voffB); PG8_STAGE(PG8_SA(0, 0), cA, voffA); PG8_STAGE(PG8_SA(0, 1), cA + hstep, voffA);
        if (wr == 1) PG8_BAR;
        PG8_WAIT_V(2); PG8_BAR;
        PG8_STAGE(PG8_SB(1, 0), cB + kstep, voffB); PG8_STAGE(PG8_SA(1, 0), cA + kstep, voffA); PG8_STAGE(PG8_SB(1, 1), cB + hstep + kstep, voffB);
        PG8_WAIT_V(6); PG8_BAR;
    } else {
        PG8_STAGE(PG8_SB(0, 0), cB, voffB); PG8_STAGE(PG8_SA(0, 0), cA, voffA); PG8_STAGE(PG8_SB(0, 1), cB + hstep, voffB); PG8_STAGE(PG8_SA(0, 1), cA + hstep, voffA);
        if (wr == 1) PG8_BAR;
        PG8_WAIT_V(4); PG8_BAR;
        PG8_STAGE(PG8_SB(1, 0), cB + kstep, voffB); PG8_STAGE(PG8_SA(1, 0), cA + kstep, voffA); PG8_STAGE(PG8_SB(1, 1), cB + hstep + kstep, voffB);
        PG8_WAIT_V(6); PG8_BAR;
    }
    for (;;) {
        const bool has_next = S.next(ui + 1, nxt);
        const char* nA = has_next ? (const char*)g.A + (size_t)nxt.pm * tstep : cA; const char* nB = has_next ? (const char*)g.Bt + (size_t)nxt.pn * tstep : cB;
        for (int t = 0; t < nt; t += 2) {
            const bool last = (t == nt - 2);
            const char* a1 = cA + (size_t)(t + 1) * kstep;
            const char* a2 = last ? nA : cA + (size_t)(t + 2) * kstep; const char* b2 = last ? nB : cB + (size_t)(t + 2) * kstep;
            const char* a3 = a2 + kstep; const char* b3 = b2 + kstep;
            if (last && has_next) S.a_ready(nxt);
            if constexpr (SP2) {
            PG8_LDB(B0, 0, 0); PG8_LDB(B1, 0, 1); PG8_SCHED; PG8_LDA(At, 0, 0); PG8_STAGE(PG8_SA(1, 1), a1 + hstep, voffA);
            PG8_WAIT_V(8); PG8_WAIT_L(0); PG8_BAR; PG8_MMA(0, 0, At, B0); PG8_MMA(0, 1, At, B1); PG8_BAR; PG8_SCHED;
            PG8_LDA(At, 0, 1); PG8_STAGE(PG8_SB(0, 0), b2, voffB); PG8_STAGE(PG8_SB(0, 1), b2 + hstep, voffB); PG8_STAGE(PG8_SA(0, 0), a2, voffA);
            PG8_WAIT_V(8); PG8_WAIT_L(0); PG8_BAR; PG8_MMA(1, 0, At, B0); PG8_MMA(1, 1, At, B1); PG8_BAR; PG8_SCHED;
            PG8_LDB(B0, 1, 0); PG8_LDB(B1, 1, 1); PG8_SCHED; PG8_LDA(At, 1, 0); PG8_STAGE(PG8_SA(0, 1), a2 + hstep, voffA);
            PG8_WAIT_V(8); PG8_WAIT_L(0); PG8_BAR; PG8_MMA(0, 0, At, B0); PG8_MMA(0, 1, At, B1); PG8_BAR; PG8_SCHED;
            PG8_LDA(At, 1, 1); PG8_STAGE(PG8_SB(1, 0), b3, voffB); PG8_STAGE(PG8_SB(1, 1), b3 + hstep, voffB); PG8_STAGE(PG8_SA(1, 0), a3, voffA);
            PG8_WAIT_V(8); PG8_WAIT_L(0); PG8_BAR; PG8_MMA(1, 0, At, B0); PG8_MMA(1, 1, At, B1); PG8_BAR; PG8_SCHED;
            } else {
            PG8_LDB(B0, 0, 0); PG8_SCHED; PG8_LDA(At, 0, 0); PG8_STAGE(PG8_SA(1, 1), a1 + hstep, voffA);
            PG8_WAIT_L(8); PG8_BAR; PG8_WAIT_L(0); PG8_MMA(0, 0, At, B0); PG8_BAR; PG8_SCHED;
            PG8_LDB(B1, 0, 1); PG8_STAGE(PG8_SB(0, 0), b2, voffB);
            PG8_BAR; PG8_WAIT_L(0); PG8_MMA(0, 1, At, B1); PG8_BAR;
            PG8_LDA(At, 0, 1); PG8_STAGE(PG8_SA(0, 0), a2, voffA);
            PG8_BAR; PG8_WAIT_L(0); PG8_MMA(1, 0, At, B0); PG8_BAR; PG8_SCHED;
            PG8_STAGE(PG8_SB(0, 1), b2 + hstep, voffB);
            PG8_WAIT_V(6); PG8_BAR; PG8_MMA(1, 1, At, B1); PG8_BAR;
            PG8_LDB(B0, 1, 0); PG8_SCHED; PG8_LDA(At, 1, 0); PG8_STAGE(PG8_SA(0, 1), a2 + hstep, voffA);
            PG8_WAIT_L(8); PG8_BAR; PG8_WAIT_L(0); PG8_MMA(0, 0, At, B0); PG8_BAR; PG8_SCHED;
            PG8_LDB(B1, 1, 1); PG8_STAGE(PG8_SB(1, 0), b3, voffB);
            PG8_BAR; PG8_WAIT_L(0); PG8_MMA(0, 1, At, B1); PG8_BAR;
            PG8_LDA(At, 1, 1); PG8_STAGE(PG8_SA(1, 0), a3, voffA);
            PG8_BAR; PG8_WAIT_L(0); PG8_MMA(1, 0, At, B0); PG8_BAR; PG8_SCHED;
            PG8_STAGE(PG8_SB(1, 1), b3 + hstep, voffB);
            PG8_WAIT_V(6); PG8_BAR; PG8_MMA(1, 1, At, B1); PG8_BAR;
            }
        }
        if constexpr (ALIGN_EPI) { if (wr == 0) PG8_BAR; }
        if constexpr (!Epi::AFTER_DRAIN) { E(acc, cur, wr, wc, fr, fq); S.done(cur); }
        if (!has_next) break;
#pragma unroll
        for (int a = 0; a < 2; ++a)
#pragma unroll
            for (int b = 0; b < 2; ++b)
#pragma unroll
                for (int m = 0; m < 4; ++m)
#pragma unroll
                    for (int n = 0; n < 2; ++n) acc[a][b][m][n] = (f32x4){0.f, 0.f, 0.f, 0.f};
        cur = nxt; cA = nA; cB = nB; ++ui;
        if constexpr (ALIGN_EPI) { if (wr == 1) PG8_BAR; }
    }
    PG8_WAIT_V(0);
    if constexpr (!ALIGN_EPI) { if (wr == 0) PG8_BAR; }
    PG8_BAR;
    if constexpr (Epi::AFTER_DRAIN) { E.fused(acc, cur, wr, wc, fr, fq, lds, wid, lane); S.done(cur); }
#undef PG8_SA
#undef PG8_SB
#undef PG8_STAGE
#undef PG8_LDA
#undef PG8_LDB
#undef PG8_MMA
#undef PG8_WAIT_V
#undef PG8_WAIT_L
#undef PG8_BAR
#undef PG8_SCHED
}
}

#define LAS __attribute__((address_space(3)))
typedef unsigned short bf16_t;
typedef unsigned v4u __attribute__((ext_vector_type(4)));
typedef unsigned v2u __attribute__((ext_vector_type(2)));
typedef float f32x4 __attribute__((ext_vector_type(4)));
typedef float f32x16 __attribute__((ext_vector_type(16)));
typedef short bf16x8 __attribute__((ext_vector_type(8)));
typedef short s16x4 __attribute__((ext_vector_type(4)));

constexpr int NWAVES = 8, NTHR = 512;
constexpr int BATCH = 2, SEQ = 8192, DM = 1024, M = BATCH * SEQ;
constexpr int DIN = 1704;
constexpr int NPROJ = 2304;
constexpr int C_QL = 0, C_CKV = 1024, C_IQ = 1152, C_IK = 1408, C_IW = 1440, C_UP = 1448, C_UC = 1704, C_END = 2216;
constexpr int KMIX = 1536;
constexpr int NE = 16, DE = 512;
constexpr int MAXSLOT = 36864;
constexpr float ALPHA = 1.41421356237309515f, LN_EPS = 1e-5f;
constexpr int TOPK = 256;

constexpr size_t MiB = 1u << 20;
constexpr size_t WS_BLKCNT = 0;
constexpr size_t WS_TILETAB = 64 * 1024;
constexpr size_t WS_BAR = 128 * 1024;
constexpr size_t WS_SSQ = 1 * MiB;
constexpr size_t WS_TOKE = 2 * MiB;
constexpr size_t WS_TOKG = 2 * MiB + 256 * 1024;
constexpr size_t WS_TOKS = 2 * MiB + 512 * 1024;
constexpr size_t WS_GSLOT = 3 * MiB;
constexpr size_t WS_WPT = 3 * MiB + 512 * 1024;
constexpr size_t WS_WIN = 4 * MiB;
constexpr size_t WS_WO = 9 * MiB;
constexpr size_t WS_WGU = 12 * MiB;
constexpr size_t WS_WD = 44 * MiB;
constexpr size_t WS_XB = 60 * MiB;
constexpr size_t WS_R = 92 * MiB;
constexpr size_t WS_PROJ = WS_R;
constexpr size_t WS_YMIX = WS_R + 72 * MiB;
constexpr size_t WS_XS = WS_R;
constexpr size_t WS_H = WS_R + 72 * MiB;
constexpr size_t WS_IKC = WS_R + 120 * MiB;
constexpr size_t WS_CKVC = WS_R + 121 * MiB;
constexpr size_t WS_REC = WS_WGU;
constexpr size_t WS_END = WS_R + 125 * MiB;
static_assert(WS_REC + (size_t)2048 * 4 * 1536 * 6 <= WS_XB + (size_t)32 * MiB, "record overlay");

constexpr int LDS_BYTES = 147456;
constexpr int LDS_MISC = 143360;

#define LDS_WAIT() asm volatile("s_waitcnt lgkmcnt(0)" ::: "memory")
#define VM_WAIT() asm volatile("s_waitcnt vmcnt(0)" ::: "memory")

__device__ __forceinline__ unsigned f2bf(float f) { unsigned u = __builtin_bit_cast(unsigned, f); return (u + 0x7fffu + ((u >> 16) & 1u)) >> 16; }
typedef float f32x2_t __attribute__((ext_vector_type(2))); typedef __bf16 bf16x2_t __attribute__((ext_vector_type(2)));
__device__ __forceinline__ unsigned pk2(float lo, float hi) { f32x2_t v = {lo, hi}; bf16x2_t b = __builtin_convertvector(v, bf16x2_t); return __builtin_bit_cast(unsigned, b); }
__device__ __forceinline__ float bflo(unsigned w) { return __builtin_bit_cast(float, w << 16); }
__device__ __forceinline__ float bfhi(unsigned w) { return __builtin_bit_cast(float, w & 0xffff0000u); }
__device__ __forceinline__ float bf2f(bf16_t v) { return __builtin_bit_cast(float, (unsigned)v << 16); }
__device__ __forceinline__ int ld_agent(const int* p) { return __hip_atomic_load(p, __ATOMIC_RELAXED, __HIP_MEMORY_SCOPE_AGENT); }
__device__ __forceinline__ float ld_agent_f(const float* p) { return __hip_atomic_load(p, __ATOMIC_RELAXED, __HIP_MEMORY_SCOPE_AGENT); }
__device__ __forceinline__ float wave_sum(float v) {
#pragma unroll
    for (int o = 1; o < 64; o <<= 1) v += __shfl_xor(v, o);
    return v;
}
__device__ __forceinline__ float sigmoidf_(float x) { return 1.0f / (1.0f + __expf(-x)); }

#define RLX_AGENT __ATOMIC_RELAXED, __HIP_MEMORY_SCOPE_AGENT
#define XB_TMO      128
#define XB_XCNT(j)  (256  + 64 * (j))
#define XB_XSUB(j)  (1280 + 64 * (j))
#define XB_XGEN(j)  (2304 + 64 * (j))
#define XB_TOP      3328
#define XB_TOPGEN   3392
#define XCD_BAR_WORDS 3456
#define XB_SPIN_CAP (1u << 18)

__device__ __forceinline__ unsigned xb_ld(unsigned* p)              { return __hip_atomic_load(p, __ATOMIC_RELAXED, __HIP_MEMORY_SCOPE_AGENT); }
__device__ __forceinline__ unsigned xb_add(unsigned* p, unsigned v) { return __hip_atomic_fetch_add(p, v, __ATOMIC_RELAXED, __HIP_MEMORY_SCOPE_AGENT); }
__device__ __forceinline__ unsigned xb_xcc_id() { return (unsigned)__builtin_amdgcn_s_getreg((3 << 11) | 20) & 0xFu; }
#define XB_SPIN(cond, bar) do { unsigned _sp = 0; while (cond) { __builtin_amdgcn_s_sleep(1); \
    if ((++_sp & 255u) == 0u) { if (xb_ld(&(bar)[XB_TMO])) break; if (_sp > XB_SPIN_CAP) { atomicAdd(&(bar)[XB_TMO], 1u); break; } } } } while (0)

struct XcdBarrier {
    unsigned* bar; unsigned x;
    volatile LAS unsigned* st;
};

__device__ __forceinline__ XcdBarrier xcd_barrier_post(unsigned* bar, volatile LAS unsigned* st) {
    XcdBarrier b; b.bar = bar; b.x = xb_xcc_id(); b.st = st;
    if (threadIdx.x == 0) (void)xb_add(&bar[XB_XCNT(b.x)], 1u);
    return b;
}
__device__ __forceinline__ void xcd_barrier_complete(unsigned* bar, unsigned x, unsigned& nloc, unsigned& nx) {
    const unsigned G = gridDim.x * gridDim.y * gridDim.z;
    unsigned sum, cnt, mine, sp = 0u;
    for (;;) {
        sum = 0u; cnt = 0u; mine = 0u;
#pragma unroll
        for (unsigned j = 0; j < 16; ++j) { const unsigned c = xb_ld(&bar[XB_XCNT(j)]); sum += c; cnt += (c > 0u) ? 1u : 0u; mine = (j == x) ? c : mine; }
        if (sum == G) break;
        __builtin_amdgcn_s_sleep(1);
        if ((++sp & 255u) == 0u) { if (xb_ld(&bar[XB_TMO])) break; if (sp > XB_SPIN_CAP) { atomicAdd(&bar[XB_TMO], 1u); break; } }
    }
    nloc = mine > 0u ? mine : 1u; nx = cnt > 0u ? cnt : 1u;
}

__device__ __forceinline__ void xcd_barrier(const XcdBarrier& b) {
    asm volatile("s_waitcnt vmcnt(0)" ::: "memory");
    __syncthreads();
    if (threadIdx.x == 0) {
        unsigned* bar = b.bar;
        __builtin_amdgcn_s_waitcnt(0);
        unsigned nloc = b.st[0], nx = b.st[1];
        if (nloc == 0u) { xcd_barrier_complete(bar, b.x, nloc, nx); b.st[0] = nloc; b.st[1] = nx; }
        const unsigned old = xb_add(&bar[XB_XSUB(b.x)], 1u);
        const unsigned gen = old / nloc;
        if (old + 1u == (gen + 1u) * nloc) {
            __builtin_amdgcn_fence(__ATOMIC_RELEASE, "agent");
            asm volatile("s_waitcnt vmcnt(0)" ::: "memory");
            const unsigned og = xb_add(&bar[XB_TOP], 1u);
            const unsigned tg = og / nx;
            if (og + 1u == (tg + 1u) * nx) xb_add(&bar[XB_TOPGEN], 1u);
            else XB_SPIN(xb_ld(&bar[XB_TOPGEN]) == tg, bar);
            __builtin_amdgcn_fence(__ATOMIC_ACQUIRE, "agent");
            xb_add(&bar[XB_XGEN(b.x)], 1u);
            asm volatile("s_waitcnt vmcnt(0)" ::: "memory");
        } else {
            XB_SPIN(xb_ld(&bar[XB_XGEN(b.x)]) == gen, bar);
            __builtin_amdgcn_fence(__ATOMIC_ACQUIRE, "agent");
            asm volatile("s_waitcnt vmcnt(0)" ::: "memory");
        }
    }
    __syncthreads();
}

struct Args {
    const float* in[21]; float* out; unsigned char* ws; int ph_lo, ph_hi, coop, pad;
};

struct Frame {
    LAS unsigned char* lds;
    int tid, lane, wave, G, bid;
};
__device__ __forceinline__ Frame relaunder(const Frame& F) { Frame L = F; int t = threadIdx.x; asm volatile("" : "+v"(t)); L.tid = t; L.lane = t & 63; L.wave = __builtin_amdgcn_readfirstlane(t >> 6); return L; }
typedef const __attribute__((address_space(4))) Args* KArgs;
__device__ __forceinline__ KArgs kargs() { KArgs p = (KArgs)__builtin_amdgcn_kernarg_segment_ptr(); asm volatile("" : "+s"(p)); return p; }
struct LayerW {
    const float *w_in, *kvg, *w_uk, *w_uv, *w_o, *w_gate, *w_up, *w_down;
};
__device__ __forceinline__ bf16_t* ws_bf(KArgs A, size_t off) { return (bf16_t*)(A->ws + off); }

struct EpiProj {
    static constexpr bool PERM = false, AFTER_DRAIN = false;
    bf16_t* O; float* ssq; bf16_t* ikc; bf16_t* ckvc;
    __device__ __forceinline__ void operator()(const f32x4 (&acc)[2][2][4][2], const pg8::Unit& u, int wr, int wc, int fr, int fq) const {
        const int col0 = u.pn * 256 + wc * 32 + 4 * fq;
#pragma unroll
        for (int ai = 0; ai < 2; ++ai)
#pragma unroll
            for (int m = 0; m < 4; ++m) {
                const int row = u.pm * 256 + ai * 128 + wr * 64 + m * 16 + fr;
                bf16_t* rowp = O + (size_t)row * NPROJ + col0;
#pragma unroll
                for (int bj = 0; bj < 2; ++bj)
#pragma unroll
                    for (int n = 0; n < 2; ++n) { const f32x4 v = acc[ai][bj][m][n]; v2u w; w.x = pk2(v[0], v[1]); w.y = pk2(v[2], v[3]); *(v2u*)(rowp + bj * 128 + n * 16) = w; }
                if (u.pn == 4) {
                    float ss = 0.f;
#pragma unroll
                    for (int n = 0; n < 2; ++n) { const f32x4 v = acc[ai][0][m][n]; ss += (v[0] * v[0] + v[1] * v[1]) + (v[2] * v[2] + v[3] * v[3]); }
                    ss += __shfl_xor(ss, 16); ss += __shfl_xor(ss, 32);
                    if (fq == 0) ssq[(size_t)row * 4 + wc] = ss;
#pragma unroll
                    for (int n = 0; n < 2; ++n) { const f32x4 v = acc[ai][0][m][n]; v2u w; w.x = pk2(v[0], v[1]); w.y = pk2(v[2], v[3]); *(v2u*)(ckvc + (size_t)row * 128 + wc * 32 + n * 16 + 4 * fq) = w; }
                }
                if (u.pn == 5 && wc == 0) {
#pragma unroll
                    for (int n = 0; n < 2; ++n) { const f32x4 v = acc[ai][1][m][n]; v2u w; w.x = pk2(v[0], v[1]); w.y = pk2(v[2], v[3]); *(v2u*)(ikc + (size_t)row * 32 + n * 16 + 4 * fq) = w; }
                }
            }
    }
};
struct EpiMix {
    static constexpr bool PERM = false, AFTER_DRAIN = false;
    const float* base; float* out;
    __device__ __forceinline__ void operator()(const f32x4 (&acc)[2][2][4][2], const pg8::Unit& u, int wr, int wc, int fr, int fq) const {
        const int col0 = u.pn * 256 + wc * 32 + 4 * fq;
#pragma unroll
        for (int ai = 0; ai < 2; ++ai)
#pragma unroll
            for (int m = 0; m < 4; ++m) {
                const size_t off = (size_t)(u.pm * 256 + ai * 128 + wr * 64 + m * 16 + fr) * DM + col0;
#pragma unroll
                for (int bj = 0; bj < 2; ++bj)
#pragma unroll
                    for (int n = 0; n < 2; ++n) { const f32x4 b = *(const f32x4*)(base + off + bj * 128 + n * 16); *(f32x4*)(out + off + bj * 128 + n * 16) = b * ALPHA + acc[ai][bj][m][n]; }
                asm volatile("" ::: "memory");
            }
    }
};
struct EpiGU {
    static constexpr bool PERM = false, AFTER_DRAIN = false;
    bf16_t* H; const float* gslot;
    __device__ __forceinline__ void operator()(const f32x4 (&acc)[2][2][4][2], const pg8::Unit& u, int wr, int wc, int fr, int fq) const {
        const int f0 = (u.pn & 3) * 128 + wc * 16 + 4 * fq;
#pragma unroll
        for (int ai = 0; ai < 2; ++ai)
#pragma unroll
            for (int m = 0; m < 4; ++m) {
                const int row = u.pm * 256 + ai * 128 + wr * 64 + m * 16 + fr;
                const float gw = gslot[row];
#pragma unroll
                for (int bj = 0; bj < 2; ++bj) {
                    const f32x4 g = acc[ai][bj][m][0], up = acc[ai][bj][m][1]; float h[4];
#pragma unroll
                    for (int i = 0; i < 4; ++i) h[i] = g[i] * sigmoidf_(g[i]) * up[i] * gw;
                    v2u w; w.x = pk2(h[0], h[1]); w.y = pk2(h[2], h[3]); *(v2u*)(H + (size_t)row * DE + f0 + bj * 64) = w;
                }
                asm volatile("" ::: "memory");
            }
    }
};
struct EpiDown {
    static constexpr bool PERM = false, AFTER_DRAIN = false;
    bf16_t* Y;
    __device__ __forceinline__ void operator()(const f32x4 (&acc)[2][2][4][2], const pg8::Unit& u, int wr, int wc, int fr, int fq) const {
        const int col0 = (u.pn & 3) * 256 + wc * 32 + 4 * fq;
#pragma unroll
        for (int ai = 0; ai < 2; ++ai)
#pragma unroll
            for (int m = 0; m < 4; ++m) {
                bf16_t* rowp = Y + (size_t)(u.pm * 256 + ai * 128 + wr * 64 + m * 16 + fr) * DM + col0;
#pragma unroll
                for (int bj = 0; bj < 2; ++bj)
#pragma unroll
                    for (int n = 0; n < 2; ++n) { const f32x4 v = acc[ai][bj][m][n]; v2u w; w.x = pk2(v[0], v[1]); w.y = pk2(v[2], v[3]); *(v2u*)(rowp + bj * 128 + n * 16) = w; }
            }
    }
};
struct GroupedOrder {
    const int* tab; int G, c, nunits;
    __device__ __forceinline__ void init(const int* tab_, int G_, int c_) { tab = tab_; G = G_; c = c_; nunits = ld_agent(tab_) * 4; }
    __device__ __forceinline__ bool next(int i, pg8::Unit& u) const {
        const int L = i * G + c; if (L >= nunits) return false;
        const int pm = L >> 2; const int e = ld_agent(tab + 1 + pm); u.pm = pm; u.pn = e * 4 + (L & 3); return true;
    }
    __device__ __forceinline__ void a_ready(const pg8::Unit&) const {}
    __device__ __forceinline__ void done(const pg8::Unit&) const {}
};

struct RowId { __device__ __forceinline__ int operator()(int n) const { return n; } };
struct RowGU { int up; __device__ __forceinline__ int operator()(int n) const { return 32 * (n >> 4) + (n & 15) + 16 * up; } };

template <class RM>
__device__ __forceinline__ void transpose_item(const float* W, int ldw, int krow0, int col0, int ncols, bf16_t* WT, int pitch, int koff, RM rm, int item, int lane) {
    const int nblk = (ncols + 63) >> 6, kb = item / nblk, nb = item - kb * nblk, k0 = 64 * kb, n = 64 * nb + lane;
    if (n >= ncols) return;
    const float* src = W + (size_t)(krow0 + k0) * ldw + col0 + n;
    bf16_t* dst = WT + (size_t)rm(n) * pitch + koff + k0;
#pragma unroll 2
    for (int c = 0; c < 8; ++c) {
        float v[8];
#pragma unroll
        for (int q = 0; q < 8; ++q) v[q] = src[(size_t)(8 * c + q) * ldw];
        v4u o; o.x = pk2(v[0], v[1]); o.y = pk2(v[2], v[3]); o.z = pk2(v[4], v[5]); o.w = pk2(v[6], v[7]);
        *(v4u*)(dst + 8 * c) = o;
    }
}

typedef float f32x2w __attribute__((ext_vector_type(2)));
template <class RM>
__device__ __forceinline__ void transpose_item2(const float* W, int ldw, int ncols, bf16_t* WT, int pitch, RM rm, int item, int lane, int krow0 = 0, int col0 = 0, int koff = 0) {
    const int nblk = (ncols + 127) >> 7, kb = item / nblk, nb = item - kb * nblk, k0 = 32 * kb, n = 128 * nb + 2 * lane;
    if (n >= ncols) return;
    const f32x2w* src = (const f32x2w*)(W + (size_t)(krow0 + k0) * ldw + col0 + n);
    f32x2w v[32];
#pragma unroll
    for (int q = 0; q < 32; ++q) v[q] = __builtin_nontemporal_load(src + (size_t)q * (ldw / 2));
    bf16_t* d0 = WT + (size_t)rm(n) * pitch + koff + k0; bf16_t* d1 = WT + (size_t)rm(n + 1) * pitch + koff + k0;
#pragma unroll
    for (int c = 0; c < 4; ++c) {
        v4u o; o.x = pk2(v[8 * c][0], v[8 * c + 1][0]); o.y = pk2(v[8 * c + 2][0], v[8 * c + 3][0]); o.z = pk2(v[8 * c + 4][0], v[8 * c + 5][0]); o.w = pk2(v[8 * c + 6][0], v[8 * c + 7][0]);
        *(v4u*)(d0 + 8 * c) = o;
        v4u u; u.x = pk2(v[8 * c][1], v[8 * c + 1][1]); u.y = pk2(v[8 * c + 2][1], v[8 * c + 3][1]); u.z = pk2(v[8 * c + 4][1], v[8 * c + 5][1]); u.w = pk2(v[8 * c + 6][1], v[8 * c + 7][1]);
        *(v4u*)(d1 + 8 * c) = u;
    }
}

__device__ __forceinline__ void absorb_q_task(const Frame& F, const float* w_in, const float* w_uk, const float* kvg, bf16_t* Win_t, int a) {
    const int h = a >> 6, kb = (a >> 2) & 15, rq = a & 3, k = kb * 64 + F.lane;
    f32x4 win[16];
    const f32x4* src = (const f32x4*)(w_in + (size_t)k * DIN + h * 64);
#pragma unroll
    for (int i = 0; i < 16; ++i) win[i] = src[i];
#pragma unroll 1
    for (int r = rq * 32; r < rq * 32 + 32; ++r) {
        const f32x4* wu = (const f32x4*)(w_uk + (size_t)(h * 128 + r) * 64);
        float acc = 0.f;
#pragma unroll
        for (int i = 0; i < 16; ++i) { const f32x4 u = wu[i]; acc += win[i][0] * u[0]; acc += win[i][1] * u[1]; acc += win[i][2] * u[2]; acc += win[i][3] * u[3]; }
        Win_t[(size_t)(h * 128 + r) * DM + k] = (bf16_t)f2bf(acc * 0.125f * kvg[r]);
    }
}
__device__ __forceinline__ void absorb_o_task(const Frame& F, const float* w_o, const float* w_uv, const float* kvg, bf16_t* Wo_t, int a) {
    const int h = a >> 6, nb = (a >> 2) & 15, rq = a & 3, n = nb * 64 + F.lane;
    float wo[64];
#pragma unroll
    for (int d = 0; d < 64; ++d) wo[d] = w_o[(size_t)(h * 64 + d) * DM + n];
#pragma unroll 1
    for (int r = rq * 32; r < rq * 32 + 32; ++r) {
        const f32x4* wu = (const f32x4*)(w_uv + (size_t)(h * 128 + r) * 64);
        float s = 0.f;
#pragma unroll
        for (int i = 0; i < 16; ++i) { const f32x4 u = wu[i]; s += wo[4 * i] * u[0]; s += wo[4 * i + 1] * u[1]; s += wo[4 * i + 2] * u[2]; s += wo[4 * i + 3] * u[3]; }
        Wo_t[(size_t)n * KMIX + h * 128 + r] = (bf16_t)f2bf(s * kvg[r]);
    }
}

__device__ __forceinline__ void phase_convert(const Frame& F0, int l, bool with_x, int part) {
    const Frame F = relaunder(F0);
    KArgs A = kargs();
    const float* w_in = A->in[1] + (size_t)l * DM * DIN; const float* kvg = A->in[2] + l * 128;
    const float* w_uk = A->in[3] + (size_t)l * 8 * 128 * 64; const float* w_uv = A->in[4] + (size_t)l * 8 * 128 * 64;
    const float* w_o = A->in[11] + (size_t)l * DM * DM;
    const float* w_gate = A->in[16] + (size_t)l * NE * DM * DE; const float* w_up = A->in[17] + (size_t)l * NE * DM * DE; const float* w_down = A->in[18] + (size_t)l * NE * DE * DM;
    bf16_t* Win_t = ws_bf(A, WS_WIN); bf16_t* Wo_t = ws_bf(A, WS_WO); bf16_t* Wgu_t = ws_bf(A, WS_WGU); bf16_t* Wd_t = ws_bf(A, WS_WD);
    const int gw = F.bid * NWAVES + F.wave, NGW = F.G * NWAVES;
    constexpr int I_AQ = 512, I_AO = 512, I_IN = 32 * 10, I_O2 = 16 * 8, I_G1 = 16 * 8, I_D1 = 8 * 16, I_Z = 88, I_WP = 4;
    constexpr int NITEMS = I_AQ + I_AO + I_IN + I_O2 + NE * (2 * I_G1 + I_D1) + I_Z + I_WP;
    constexpr int I_A = I_AQ + I_AO + I_IN + I_O2, I_MOE = NE * (2 * I_G1 + I_D1);
    const int it_lo = part == 0 ? 0 : I_A, it_hi = part == 0 ? NITEMS : I_A + I_MOE;
#pragma unroll 1
    for (int it = it_lo + gw; it < it_hi; it += NGW) {
        if (part == 0 && it >= I_A && it < I_A + I_MOE) continue;
        int r = it;
#ifndef NO_AQ
        if (r < I_AQ) { absorb_q_task(F, w_in, w_uk, kvg, Win_t, r); continue; }
#endif
        r -= I_AQ;
#ifndef NO_AO
        if (r < I_AO) { absorb_o_task(F, w_o, w_uv, kvg, Wo_t, r); continue; }
#endif
        r -= I_AO;
        if (r < I_IN) { transpose_item2(w_in, DIN, DIN - 512, Win_t + (size_t)1024 * DM, DM, RowId{}, r, F.lane, 0, 512, 0); continue; } r -= I_IN;
        if (r < I_O2) { transpose_item2(w_o, DM, DM, Wo_t, KMIX, RowId{}, r, F.lane, 512, 0, 1024); continue; } r -= I_O2;
        if (r < NE * 2 * I_G1) { const int e = r / (2 * I_G1), q = r % (2 * I_G1), up = q / I_G1, item = q % I_G1;
            transpose_item2((up ? w_up : w_gate) + (size_t)e * DM * DE, DE, DE, Wgu_t + (size_t)e * 1024 * DM, DM, RowGU{up}, item, F.lane); continue; } r -= NE * 2 * I_G1;
        if (r < NE * I_D1) { const int e = r / I_D1, item = r % I_D1;
            transpose_item2(w_down + (size_t)e * DE * DM, DM, DM, Wd_t + (size_t)e * 1024 * DE, DE, RowId{}, item, F.lane); continue; } r -= NE * I_D1;
        if (r < I_Z) { v4u z = {0u, 0u, 0u, 0u}; v4u* p = (v4u*)(Win_t + (size_t)(C_END + r) * DM); p[F.lane] = z; p[F.lane + 64] = z; continue; } r -= I_Z;
        transpose_item(A->in[5] + (size_t)l * 4 * 64 * 64 + (size_t)r * 64 * 64, 64, 0, 0, 64, ws_bf(A, WS_WPT) + (size_t)r * 64 * 64, 64, 0, RowId{}, 0, F.lane);
    }
    if (with_x) {
        const float* x = A->in[0]; bf16_t* xb = ws_bf(A, WS_XB);
#pragma unroll 1
        for (int m = gw; m < M; m += NGW) {
            const f32x4* xr = (const f32x4*)(x + (size_t)m * DM) + F.lane; v2u* o = (v2u*)(xb + (size_t)m * DM) + F.lane;
#pragma unroll
            for (int j = 0; j < 4; ++j) { const f32x4 v = xr[64 * j]; v2u w; w.x = pk2(v[0], v[1]); w.y = pk2(v[2], v[3]); o[64 * j] = w; }
        }
    }
}

struct MixP { unsigned* rec; const bf16_t* proj; const bf16_t* ikc; const bf16_t* ckvc; bf16_t* ymix; const bf16_t* wpt; const float *ssq, *conv_w, *conv_b, *cln_g, *cln_b, *pool_scale; };
__device__ __forceinline__ void conv_pool_tile(const Frame& F, const MixP& P, int tile) {
    const int tid = F.tid, lane = F.lane, wave = F.wave;
    const int row0 = tile * 32;
    const int tpos0 = row0 & (SEQ - 1);
    LAS float* hbuf = (LAS float*)F.lds;
    LAS float* cout = (LAS float*)(F.lds + 63488);
#pragma unroll 1
    for (int task = tid; task < 62 * 32; task += NTHR) {
        const int j = task >> 5, c8 = (task & 31) * 8; const int tp = tpos0 - 30 + j;
        f32x4 h0 = {0.f, 0.f, 0.f, 0.f}, h1 = {0.f, 0.f, 0.f, 0.f};
        if (tp >= 0) {
            const bf16_t* p = P.proj + (size_t)(row0 - 30 + j) * NPROJ + C_UC + c8;
            const v4u a = *(const v4u*)p, g = *(const v4u*)(p + 256);
            h0[0] = bflo(a.x) * sigmoidf_(bflo(g.x)); h0[1] = bfhi(a.x) * sigmoidf_(bfhi(g.x)); h0[2] = bflo(a.y) * sigmoidf_(bflo(g.y)); h0[3] = bfhi(a.y) * sigmoidf_(bfhi(g.y));
            h1[0] = bflo(a.z) * sigmoidf_(bflo(g.z)); h1[1] = bfhi(a.z) * sigmoidf_(bfhi(g.z)); h1[2] = bflo(a.w) * sigmoidf_(bflo(g.w)); h1[3] = bfhi(a.w) * sigmoidf_(bfhi(g.w));
        }
        *(LAS f32x4*)(hbuf + j * 256 + c8) = h0; *(LAS f32x4*)(hbuf + j * 256 + c8 + 4) = h1;
    }
    __syncthreads();
    {
        const int c = tid & 255, half = tid >> 8;
        float w[31], hv[46];
#pragma unroll
        for (int j = 0; j < 31; ++j) w[j] = P.conv_w[j * 256 + c];
#pragma unroll
        for (int j = 0; j < 46; ++j) hv[j] = hbuf[(16 * half + j) * 256 + c];
        const float bias = P.conv_b[c];
#pragma unroll
        for (int i = 0; i < 16; ++i) {
            float a0 = bias, a1 = 0.f;
#pragma unroll
            for (int j = 0; j < 30; j += 2) { a0 = fmaf(hv[i + j], w[j], a0); a1 = fmaf(hv[i + j + 1], w[j + 1], a1); }
            a0 = fmaf(hv[i + 30], w[30], a0);
            cout[(16 * half + i) * 256 + c] = a0 + a1;
        }
    }
    __syncthreads();
#pragma unroll 1
    for (int i = wave; i < 32; i += NWAVES) {
        const f32x4 x = *(LAS f32x4*)(cout + i * 256 + 4 * lane);
        const float mean = wave_sum((x[0] + x[1]) + (x[2] + x[3])) * (1.f / 256.f);
        const f32x4 d = x - mean;
        const float var = wave_sum((d[0] * d[0] + d[1] * d[1]) + (d[2] * d[2] + d[3] * d[3])) * (1.f / 256.f);
        const float rstd = 1.0f / sqrtf(var + LN_EPS);
        const f32x4 g = *(const f32x4*)(P.cln_g + 4 * lane), b = *(const f32x4*)(P.cln_b + 4 * lane);
        float y[4];
#pragma unroll
        for (int k = 0; k < 4; ++k) { const float z = d[k] * rstd * g[k] + b[k]; y[k] = z * sigmoidf_(z); }
        v2u w; w.x = pk2(y[0], y[1]); w.y = pk2(y[2], y[3]);
        *(v2u*)(P.ymix + (size_t)(row0 + i) * KMIX + 1280 + 4 * lane) = w;
    }
    __syncthreads();
    LAS float* pbuf = (LAS float*)F.lds; LAS unsigned char* plb = F.lds + 49152;
#pragma unroll 1
    for (int task = tid; task < 47 * 32; task += NTHR) {
        const int j = task >> 5, c8 = (task & 31) * 8; const int tp = tpos0 - 15 + j;
        f32x4 h0 = {0.f, 0.f, 0.f, 0.f}, h1 = {0.f, 0.f, 0.f, 0.f};
        if (tp >= 0) {
            const v4u a = *(const v4u*)(P.proj + (size_t)(row0 - 15 + j) * NPROJ + C_UP + c8);
            h0[0] = bflo(a.x); h0[1] = bfhi(a.x); h0[2] = bflo(a.y); h0[3] = bfhi(a.y); h1[0] = bflo(a.z); h1[1] = bfhi(a.z); h1[2] = bflo(a.w); h1[3] = bfhi(a.w);
        }
        *(LAS f32x4*)(pbuf + j * 256 + c8) = h0; *(LAS f32x4*)(pbuf + j * 256 + c8 + 4) = h1;
    }
    __syncthreads();
    {
        const int c = tid & 255, half = tid >> 8, gi = c >> 6, cl = c & 63, w = 2 << gi;
#pragma unroll 1
        for (int i = 0; i < 16; ++i) {
            const int t = half * 16 + i; float s = 0.f;
            for (int j = 0; j < w; ++j) s += pbuf[(t + 15 - j) * 256 + c];
            const int tp = tpos0 + t; const float cnt = (float)((tp + 1) < w ? (tp + 1) : w);
            const float v = s / cnt - pbuf[(t + 15) * 256 + c];
            *(LAS bf16_t*)(plb + gi * 4096 + t * 128 + (((cl >> 3) ^ (t & 7)) * 16) + (cl & 7) * 2) = (bf16_t)f2bf(v);
        }
    }
    __syncthreads();
    {
        const int g = wave >> 1, ct = wave & 1, r32 = lane & 31, kk = lane >> 5;
        f32x16 acc = {0.f, 0.f, 0.f, 0.f, 0.f, 0.f, 0.f, 0.f, 0.f, 0.f, 0.f, 0.f, 0.f, 0.f, 0.f, 0.f};
        const bf16_t* wb = P.wpt + (size_t)(g * 64 + ct * 32 + r32) * 64 + 8 * kk;
#pragma unroll
        for (int ks = 0; ks < 4; ++ks) {
            const bf16x8 a = *(LAS bf16x8*)(plb + g * 4096 + r32 * 128 + (((2 * ks + kk) ^ (r32 & 7)) * 16));
            const bf16x8 bfr = *(const bf16x8*)(wb + 16 * ks);
            acc = __builtin_amdgcn_mfma_f32_32x32x16_bf16(a, bfr, acc, 0, 0, 0);
        }
        const int d = g * 64 + ct * 32 + r32; const float sc = P.pool_scale[d];
#pragma unroll
        for (int r = 0; r < 16; ++r) { const int t = (r & 3) + 8 * (r >> 2) + 4 * kk; P.ymix[(size_t)(row0 + t) * KMIX + 1024 + d] = (bf16_t)f2bf(acc[r] * sc); }
    }
    __syncthreads();
}

__device__ __forceinline__ unsigned f2ord(float f) { const int x = __builtin_bit_cast(int, f); return (unsigned)x ^ ((unsigned)(x >> 31) | 0x80000000u); }
__device__ __forceinline__ float relu_i(float x) { const int i = __builtin_bit_cast(int, x); return __builtin_bit_cast(float, i > 0 ? i : 0); }

__device__ __forceinline__ void hist_scan(LAS unsigned* h, unsigned need, int lane, int& bin, unsigned& above, unsigned& binc) {
    const v4u c = *(LAS v4u*)(h + 4 * lane);
    const unsigned T = c.x + c.y + c.z + c.w;
    unsigned X = T;
#pragma unroll
    for (int o = 1; o < 64; o <<= 1) { const unsigned y = __shfl_down(X, o); if (lane + o < 64) X += y; }
    const unsigned long long mk = __ballot(X >= need);
    const int L = mk ? (63 - __clzll(mk)) : 0;
    const unsigned S3 = X - T + c.w, S2 = S3 + c.z, S1 = S2 + c.y;
    int bl; unsigned ab, bc;
    if (S3 >= need) { bl = 3; ab = X - T; bc = c.w; } else if (S2 >= need) { bl = 2; ab = S3; bc = c.z; } else if (S1 >= need) { bl = 1; ab = S2; bc = c.y; } else { bl = 0; ab = S1; bc = c.x; }
    bin = __shfl(4 * lane + bl, L); above = (unsigned)__shfl((int)ab, L); binc = (unsigned)__shfl((int)bc, L);
}
__device__ __forceinline__ void hist_scan512(LAS unsigned* h, unsigned need, int lane, int& bin, unsigned& above, unsigned& binc) {
    const v4u c0 = *(LAS v4u*)(h + 8 * lane), c1 = *(LAS v4u*)(h + 8 * lane + 4);
    const unsigned cc[8] = {c0.x, c0.y, c0.z, c0.w, c1.x, c1.y, c1.z, c1.w};
    const unsigned T = ((c0.x + c0.y) + (c0.z + c0.w)) + ((c1.x + c1.y) + (c1.z + c1.w));
    unsigned X = T;
#pragma unroll
    for (int o = 1; o < 64; o <<= 1) { const unsigned y = __shfl_down(X, o); if (lane + o < 64) X += y; }
    const unsigned long long mk = __ballot(X >= need);
    const int L = mk ? (63 - __clzll(mk)) : 0;
    unsigned S = X - T; int bl = 0; unsigned ab = S, bc = 0u; bool found = false;
#pragma unroll
    for (int k = 7; k >= 0; --k) { const unsigned Sn = S + cc[k]; if (!found && Sn >= need) { found = true; bl = k; ab = S; bc = cc[k]; } S = Sn; }
    bin = __shfl(8 * lane + bl, L); above = (unsigned)__shfl((int)ab, L); binc = (unsigned)__shfl((int)bc, L);
}

__device__ __forceinline__ int swz16(int row) { return ((row & 3) << 2) | ((row >> 2) & 3); }

constexpr int CAND_CAP = 256;
constexpr int WPRIV = 12800;
constexpr int RCAP = 1536;
#ifndef REP_IDX
#define REP_IDX 0
#endif
#ifndef REP_ATT
#define REP_ATT 0
#endif
#ifndef ABL_FLAGS
#define ABL_FLAGS 0
#endif

struct IdxState {
    unsigned prefix0, prefix1, need0, need1;
    unsigned eqt0, eqt1, cnt0, cnt1, cc0, cc1;
    unsigned blo0, blo1;
    unsigned rc0, rc1;
    float inv0, inv1, c00, c01;
    float ss0[8], ss1[8];
};
struct IdxConst {
    bf16x8 A0, A1; float wq[2][8]; int tqj0, tqj1; int hh, kl, rd0, rd1;
    LAS unsigned* hist; LAS unsigned short* sel; LAS unsigned* cand_u; LAS unsigned short* cand_i;
    int shift; unsigned himask; int abl;
    unsigned* rec_u; unsigned short* rec_i;
};
__device__ __forceinline__ unsigned lin_bin(float s, float inv, float c0) { return (unsigned)__builtin_amdgcn_fmed3f(fmaf(s, inv, c0), 0.f, 511.f); }

__device__ __forceinline__ void tile_scores(const IdxConst& C, const f32x16& acc, float& s0, float& s1) {
    float a0 = C.wq[0][0] * relu_i(acc[0]), b0 = C.wq[0][4] * relu_i(acc[4]), a1 = C.wq[1][0] * relu_i(acc[8]), b1 = C.wq[1][4] * relu_i(acc[12]);
#pragma unroll
    for (int h = 1; h < 4; ++h) { a0 = fmaf(C.wq[0][h], relu_i(acc[h]), a0); b0 = fmaf(C.wq[0][4 + h], relu_i(acc[4 + h]), b0); a1 = fmaf(C.wq[1][h], relu_i(acc[8 + h]), a1); b1 = fmaf(C.wq[1][4 + h], relu_i(acc[12 + h]), b1); }
    s0 = (a0 + b0) + 0.0f; s1 = (a1 + b1) + 0.0f;
}
template <int MODE>
__device__ __forceinline__ void tile_post(const IdxConst& C, IdxState& S, const f32x16& acc, int tile, int tl) {
    float s0, s1; tile_scores(C, acc, s0, s1);
    const int kidx = tile * 32 + C.kl;
    const bool v0 = kidx <= C.tqj0, v1 = kidx <= C.tqj1;
    const int hh = C.hh;
    if constexpr (MODE == 6) { S.ss0[tl] = s0; S.ss1[tl] = s1; }
    else if constexpr (MODE == 9) {
        const unsigned b0 = lin_bin(s0, S.inv0, S.c00), b1 = lin_bin(s1, S.inv1, S.c01);
        const unsigned ltm = (1u << C.kl) - 1u;
        {   const bool ps = v0 && (b0 >= S.blo0);
            if (ps) __hip_atomic_fetch_add(C.hist + (2 * hh) * 512 + b0, 1u, __ATOMIC_RELAXED, __HIP_MEMORY_SCOPE_WORKGROUP);
            const unsigned long long mt = __ballot(ps); const unsigned t32 = hh ? (unsigned)(mt >> 32) : (unsigned)mt;
            const unsigned pos = S.rc0 + __popc(t32 & ltm);
            if (ps && pos < (unsigned)RCAP && !(C.abl & 4)) { __builtin_nontemporal_store(__builtin_bit_cast(unsigned, s0), C.rec_u + (2 * hh) * RCAP + pos); __builtin_nontemporal_store((unsigned short)kidx, C.rec_i + (2 * hh) * RCAP + pos); }
            S.rc0 += __popc(t32); }
        {   const bool ps = v1 && (b1 >= S.blo1);
            if (ps) __hip_atomic_fetch_add(C.hist + (2 * hh + 1) * 512 + b1, 1u, __ATOMIC_RELAXED, __HIP_MEMORY_SCOPE_WORKGROUP);
            const unsigned long long mt = __ballot(ps); const unsigned t32 = hh ? (unsigned)(mt >> 32) : (unsigned)mt;
            const unsigned pos = S.rc1 + __popc(t32 & ltm);
            if (ps && pos < (unsigned)RCAP && !(C.abl & 4)) { __builtin_nontemporal_store(__builtin_bit_cast(unsigned, s1), C.rec_u + (2 * hh + 1) * RCAP + pos); __builtin_nontemporal_store((unsigned short)kidx, C.rec_i + (2 * hh + 1) * RCAP + pos); }
            S.rc1 += __popc(t32); }
    } else if constexpr (MODE == 0) {
        const unsigned u0 = f2ord(s0), u1 = f2ord(s1);
        if (v0 && ((u0 & C.himask) == S.prefix0)) __hip_atomic_fetch_add(C.hist + (2 * hh) * 256 + ((u0 >> C.shift) & 255u), 1u, __ATOMIC_RELAXED, __HIP_MEMORY_SCOPE_WORKGROUP);
        if (v1 && ((u1 & C.himask) == S.prefix1)) __hip_atomic_fetch_add(C.hist + (2 * hh + 1) * 256 + ((u1 >> C.shift) & 255u), 1u, __ATOMIC_RELAXED, __HIP_MEMORY_SCOPE_WORKGROUP);
    } else {
        const unsigned u0 = f2ord(s0), u1 = f2ord(s1);
        const unsigned ltm = (1u << C.kl) - 1u;
        {   const bool eq = v0 && (u0 == S.prefix0), gt = v0 && (u0 > S.prefix0);
            const unsigned long long me = __ballot(eq); const unsigned m32 = hh ? (unsigned)(me >> 32) : (unsigned)me;
            const bool take = gt || (eq && (S.eqt0 + __popc(m32 & ltm) < S.need0)); S.eqt0 += __popc(m32);
            const unsigned long long mt = __ballot(take); const unsigned t32 = hh ? (unsigned)(mt >> 32) : (unsigned)mt;
            const unsigned pos = S.cnt0 + __popc(t32 & ltm); if (take && pos < TOPK) C.sel[(2 * hh) * 256 + pos] = (unsigned short)kidx; S.cnt0 += __popc(t32); }
        {   const bool eq = v1 && (u1 == S.prefix1), gt = v1 && (u1 > S.prefix1);
            const unsigned long long me = __ballot(eq); const unsigned m32 = hh ? (unsigned)(me >> 32) : (unsigned)me;
            const bool take = gt || (eq && (S.eqt1 + __popc(m32 & ltm) < S.need1)); S.eqt1 += __popc(m32);
            const unsigned long long mt = __ballot(take); const unsigned t32 = hh ? (unsigned)(mt >> 32) : (unsigned)mt;
            const unsigned pos = S.cnt1 + __popc(t32 & ltm); if (take && pos < TOPK) C.sel[(2 * hh + 1) * 256 + pos] = (unsigned short)kidx; S.cnt1 += __popc(t32); }
    }
}
__device__ __forceinline__ f32x16 tile_mfma(const IdxConst& C, LAS unsigned char* buf, int tl) {
    const bf16x8 B0 = *(LAS bf16x8*)(buf + tl * 2048 + C.rd0), B1 = *(LAS bf16x8*)(buf + tl * 2048 + C.rd1);
    f32x16 a = {0.f, 0.f, 0.f, 0.f, 0.f, 0.f, 0.f, 0.f, 0.f, 0.f, 0.f, 0.f, 0.f, 0.f, 0.f, 0.f};
    a = __builtin_amdgcn_mfma_f32_32x32x16_bf16(C.A0, B0, a, 0, 0, 0);
    return __builtin_amdgcn_mfma_f32_32x32x16_bf16(C.A1, B1, a, 0, 0, 0);
}
template <int MODE>
__device__ __forceinline__ void idx_sweep(const IdxConst& C, IdxState& S, LAS unsigned char* ikbuf, const bf16_t* ikb, int tid, int ntile, int nchunk, int nkeys, int sstride) {
    constexpr bool sample = (MODE == 6);
    const int sr0 = tid >> 2, sc = tid & 3;
    const int sdst0 = sr0 * 64 + ((sc ^ ((sr0 >> 2) & 3)) * 16), sdst1 = (sr0 + 128) * 64 + ((sc ^ (((sr0 + 128) >> 2) & 3)) * 16);
    const int nch = sample ? 1 : nchunk;
    v4u sa = {0u, 0u, 0u, 0u}, sb = {0u, 0u, 0u, 0u};
    {   const int ka = sample ? ((sr0 >> 5) * sstride * 32 + (sr0 & 31)) : sr0, kb = sample ? ((((sr0 + 128) >> 5) * sstride) * 32 + (sr0 & 31)) : (sr0 + 128);
        if (ka < nkeys) sa = *(const v4u*)(ikb + (size_t)ka * 32 + sc * 8);
        if (kb < nkeys) sb = *(const v4u*)(ikb + (size_t)kb * 32 + sc * 8); }
    *(LAS v4u*)(ikbuf + sdst0) = sa; *(LAS v4u*)(ikbuf + sdst1) = sb;
    __syncthreads();
#pragma unroll 1
    for (int ci = 0; ci < nch; ++ci) {
        const bool more = (ci + 1) < nch;
        if (more) { const int k0 = (ci + 1) * 256;
            sa = (v4u){0u, 0u, 0u, 0u}; sb = sa;
            if (k0 + sr0 < nkeys) sa = *(const v4u*)(ikb + (size_t)(k0 + sr0) * 32 + sc * 8);
            if (k0 + sr0 + 128 < nkeys) sb = *(const v4u*)(ikb + (size_t)(k0 + sr0 + 128) * 32 + sc * 8); }
        LAS unsigned char* buf = ikbuf + (ci & 1) * 16384;
        f32x16 accA = tile_mfma(C, buf, 0), accB;
#pragma unroll
        for (int tl = 0; tl < 8; tl += 2) {
            accB = tile_mfma(C, buf, tl + 1);
            tile_post<MODE>(C, S, accA, ci * 8 + tl, tl);
            if (tl + 2 < 8) accA = tile_mfma(C, buf, tl + 2);
            tile_post<MODE>(C, S, accB, ci * 8 + tl + 1, tl + 1);
        }
        if (more) { LAS unsigned char* nb = ikbuf + ((ci + 1) & 1) * 16384; *(LAS v4u*)(nb + sdst0) = sa; *(LAS v4u*)(nb + sdst1) = sb; }
        __syncthreads();
    }
}

__device__ __forceinline__ void dsa_group(const Frame& F, const MixP& P, int b, int t0) {
    int tid_ = F.tid; asm volatile("" : "+v"(tid_));
    const int tid = tid_, lane = tid & 63, w = F.wave, hh = lane >> 5, kl = lane & 31;
    LAS unsigned char* ikbuf = F.lds;
    LAS unsigned char* wl = F.lds + 32768 + w * WPRIV;
    LAS unsigned short* sel = (LAS unsigned short*)wl;
    LAS unsigned* hist = (LAS unsigned*)(wl + 2048);
    LAS unsigned char* cbuf = wl + 2048;
    LAS unsigned* cand_u = (LAS unsigned*)(wl + 2048);
    LAS unsigned short* cand_i = (LAS unsigned short*)(wl + 2048 + 4096);
    LAS bf16_t* obuf = (LAS bf16_t*)(wl + 10240);
    LAS float* rsbuf = (LAS float*)(wl + 12544);
    LAS unsigned* flag = (LAS unsigned*)(F.lds + LDS_MISC + 256);
    const bf16_t* projb = P.proj + (size_t)b * SEQ * NPROJ;
    const bf16_t* ikb = P.ikc + (size_t)b * SEQ * 32;
    const bf16_t* ckvb = P.ckvc + (size_t)b * SEQ * 128;
    const float* ssqb = P.ssq + (size_t)b * SEQ * 4;
    const int tq0 = t0 + 4 * w;

    for (int repi = 0; repi < 1 + REP_IDX; ++repi)
    if (t0 >= TOPK) {
        IdxConst C; IdxState S;
        C.abl = (repi < REP_IDX) ? ABL_FLAGS : 0;
        { const int r = kl, qa = 2 * ((r >> 2) & 1) + (r >> 4), head = (r & 3) + 4 * ((r >> 3) & 1);
          const bf16_t* ap = projb + (size_t)(tq0 + qa) * NPROJ + C_IQ + head * 32 + 8 * hh;
          C.A0 = *(const bf16x8*)ap; C.A1 = *(const bf16x8*)(ap + 16); }
#pragma unroll
        for (int j = 0; j < 2; ++j) { const v4u v = *(const v4u*)(projb + (size_t)(tq0 + 2 * hh + j) * NPROJ + C_IW);
            C.wq[j][0] = bflo(v.x); C.wq[j][1] = bfhi(v.x); C.wq[j][2] = bflo(v.y); C.wq[j][3] = bfhi(v.y); C.wq[j][4] = bflo(v.z); C.wq[j][5] = bfhi(v.z); C.wq[j][6] = bflo(v.w); C.wq[j][7] = bfhi(v.w); }
        C.tqj0 = tq0 + 2 * hh; C.tqj1 = C.tqj0 + 1; C.hh = hh; C.kl = kl;
        C.rd0 = kl * 64 + ((hh ^ ((kl >> 2) & 3)) * 16); C.rd1 = kl * 64 + (((hh + 2) ^ ((kl >> 2) & 3)) * 16);
        C.hist = hist; C.sel = sel; C.cand_u = cand_u; C.cand_i = cand_i; C.shift = 24; C.himask = 0u;
        const int ntile = (t0 >> 5) + 1, nchunk = (ntile + 7) >> 3, nkeys = ntile * 32, sstride = ntile >> 3;
        { const v4u z = {0u, 0u, 0u, 0u};
#pragma unroll
          for (int i = 0; i < 8; ++i) *(LAS v4u*)(hist + 4 * (lane + 64 * i)) = z; }
        if (tid == 0) flag[0] = 0u;
        S.prefix0 = 0u; S.prefix1 = 0u; S.need0 = TOPK; S.need1 = TOPK; S.eqt0 = 0u; S.eqt1 = 0u; S.cnt0 = 0u; S.cnt1 = 0u; S.cc0 = 0u; S.cc1 = 0u;
        S.rc0 = 0u; S.rc1 = 0u;
        C.rec_u = P.rec + (size_t)(F.bid * NWAVES + w) * (4 * RCAP * 6 / 4); C.rec_i = (unsigned short*)(C.rec_u + 4 * RCAP);
        S.blo0 = 0u; S.blo1 = 0u; S.inv0 = 0.f; S.inv1 = 0.f; S.c00 = 0.f; S.c01 = 0.f;
        idx_sweep<6>(C, S, ikbuf, ikb, tid, ntile, nchunk, nkeys, sstride);
        bool fast;
        {
            float sum0 = 0.f, sum1 = 0.f, sq0 = 0.f, sq1 = 0.f;
#pragma unroll
            for (int r = 0; r < 8; ++r) { sum0 += S.ss0[r]; sq0 = fmaf(S.ss0[r], S.ss0[r], sq0); sum1 += S.ss1[r]; sq1 = fmaf(S.ss1[r], S.ss1[r], sq1); }
#pragma unroll
            for (int o = 1; o < 32; o <<= 1) { sum0 += __shfl_xor(sum0, o); sq0 += __shfl_xor(sq0, o); sum1 += __shfl_xor(sum1, o); sq1 += __shfl_xor(sq1, o); }
            const float m0 = sum0 * (1.f / 256.f), m1 = sum1 * (1.f / 256.f);
            const float sd0 = sqrtf(fmaxf(sq0 * (1.f / 256.f) - m0 * m0, 0.f)), sd1 = sqrtf(fmaxf(sq1 * (1.f / 256.f) - m1 * m1, 0.f));
            const bool ok = (sd0 > 1e-30f) && (sd0 < 1e30f) && (sd1 > 1e-30f) && (sd1 < 1e30f);
            S.inv0 = 512.f / (11.f * sd0); S.inv1 = 512.f / (11.f * sd1);
            S.c00 = -(m0 - 5.f * sd0) * S.inv0; S.c01 = -(m1 - 5.f * sd1) * S.inv1;
            unsigned sb0[8], sb1[8];
#pragma unroll
            for (int r = 0; r < 8; ++r) { sb0[r] = lin_bin(S.ss0[r], S.inv0, S.c00); sb1[r] = lin_bin(S.ss1[r], S.inv1, S.c01); }
            const float ks0 = 65536.f / (float)(C.tqj0 + 1), ks1 = 65536.f / (float)(C.tqj1 + 1);
            const float kf0 = ks0 + 5.f * sqrtf(ks0) + 4.f, kf1 = ks1 + 5.f * sqrtf(ks1) + 4.f;
            const unsigned klo0 = kf0 >= 255.f ? 257u : (unsigned)kf0 + 1u, klo1 = kf1 >= 255.f ? 257u : (unsigned)kf1 + 1u;
            unsigned lo0 = 0u, hi0 = 512u, lo1 = 0u, hi1 = 512u;
#pragma unroll 1
            for (int step = 0; step < 9; ++step) {
                const unsigned mid0 = (lo0 + hi0) >> 1, mid1 = (lo1 + hi1) >> 1;
                unsigned n0 = 0u, n1 = 0u;
#pragma unroll
                for (int r = 0; r < 8; ++r) { n0 += (sb0[r] >= mid0) ? 1u : 0u; n1 += (sb1[r] >= mid1) ? 1u : 0u; }
#pragma unroll
                for (int o = 1; o < 32; o <<= 1) { n0 += (unsigned)__shfl_xor((int)n0, o); n1 += (unsigned)__shfl_xor((int)n1, o); }
                if (n0 >= klo0) lo0 = mid0; else hi0 = mid0;
                if (n1 >= klo1) lo1 = mid1; else hi1 = mid1;
            }
            S.blo0 = lo0; S.blo1 = lo1;
            if (__any(!ok) && lane == 0) __hip_atomic_fetch_or(flag, 1u, __ATOMIC_RELAXED, __HIP_MEMORY_SCOPE_WORKGROUP);
            LDS_WAIT();
            __syncthreads();
            fast = (flag[0] == 0u);
        }
        if (fast) {
            idx_sweep<9>(C, S, ikbuf, ikb, tid, ntile, nchunk, nkeys, sstride);
            LDS_WAIT();
            bool good = true;
#pragma unroll
            for (int qq = 0; qq < 4; ++qq) {
                int bin; unsigned above, binc;
                hist_scan512(hist + qq * 512, (unsigned)TOPK, lane, bin, above, binc);
                const unsigned tot = above + binc;
                if (hh == (qq >> 1)) { if (qq & 1) { S.prefix1 = (unsigned)bin; S.need1 = TOPK - above; } else { S.prefix0 = (unsigned)bin; S.need0 = TOPK - above; } }
                good = good && (binc <= (unsigned)CAND_CAP) && (tot >= (unsigned)TOPK);
            }
            good = good && !__any((S.rc0 > (unsigned)RCAP) || (S.rc1 > (unsigned)RCAP));
            { const v4u z = {0u, 0u, 0u, 0u};
#pragma unroll
              for (int i = 0; i < 8; ++i) *(LAS v4u*)(hist + 4 * (lane + 64 * i)) = z; }
            if (!good && lane == 0) __hip_atomic_fetch_or(flag, 1u, __ATOMIC_RELAXED, __HIP_MEMORY_SCOPE_WORKGROUP);
            VM_WAIT();
            LDS_WAIT();
            __syncthreads();
            fast = (flag[0] == 0u);
        }
        if (fast && !(C.abl & 8)) {
            unsigned Rq[4], bstq[4], ndq[4], cq[4], cn[4]; float invq[4], c0q[4]; unsigned Rmax = 0u;
#pragma unroll
            for (int qq = 0; qq < 4; ++qq) {
                const int own = (qq >> 1) * 32;
                Rq[qq] = (unsigned)__shfl((int)((qq & 1) ? S.rc1 : S.rc0), own); bstq[qq] = (unsigned)__shfl((int)((qq & 1) ? S.prefix1 : S.prefix0), own); ndq[qq] = (unsigned)__shfl((int)((qq & 1) ? S.need1 : S.need0), own);
                invq[qq] = __shfl((qq & 1) ? S.inv1 : S.inv0, own); c0q[qq] = __shfl((qq & 1) ? S.c01 : S.c00, own);
                cq[qq] = 0u; cn[qq] = 0u; Rmax = Rq[qq] > Rmax ? Rq[qq] : Rmax;
            }
            const unsigned long long ltm64 = (1ull << lane) - 1ull;
            unsigned ubn[4], ixn[4];
#pragma unroll
            for (int qq = 0; qq < 4; ++qq) { const unsigned ii = (unsigned)lane < Rq[qq] ? (unsigned)lane : 0u;
                ubn[qq] = __hip_atomic_load(C.rec_u + qq * RCAP + ii, __ATOMIC_RELAXED, __HIP_MEMORY_SCOPE_AGENT); ixn[qq] = __hip_atomic_load(C.rec_i + qq * RCAP + ii, __ATOMIC_RELAXED, __HIP_MEMORY_SCOPE_AGENT); }
#pragma unroll 1
            for (unsigned base = 0; base < Rmax; base += 64) {
                const unsigned i = base + lane;
                unsigned ub[4], ix[4];
#pragma unroll
                for (int qq = 0; qq < 4; ++qq) { ub[qq] = ubn[qq]; ix[qq] = ixn[qq]; }
                if (base + 64 < Rmax) {
#pragma unroll
                    for (int qq = 0; qq < 4; ++qq) { const unsigned ii = (i + 64) < Rq[qq] ? (i + 64) : 0u;
                        ubn[qq] = __hip_atomic_load(C.rec_u + qq * RCAP + ii, __ATOMIC_RELAXED, __HIP_MEMORY_SCOPE_AGENT); ixn[qq] = __hip_atomic_load(C.rec_i + qq * RCAP + ii, __ATOMIC_RELAXED, __HIP_MEMORY_SCOPE_AGENT); }
                }
#pragma unroll
                for (int qq = 0; qq < 4; ++qq) {
                    const bool in = i < Rq[qq];
                    const float sv = __builtin_bit_cast(float, ub[qq]);
                    const unsigned bb = lin_bin(sv, invq[qq], c0q[qq]);
                    const bool gt = in && (bb > bstq[qq]), eq = in && (bb == bstq[qq]);
                    const unsigned long long mg = __ballot(gt), me = __ballot(eq);
                    const unsigned pos = cq[qq] + __popcll(mg & ltm64); if (gt && pos < TOPK) sel[qq * 256 + pos] = (unsigned short)ix[qq]; cq[qq] += __popcll(mg);
                    const unsigned cp = cn[qq] + __popcll(me & ltm64); if (eq && cp < (unsigned)CAND_CAP) { cand_u[qq * CAND_CAP + cp] = f2ord(sv); cand_i[qq * CAND_CAP + cp] = (unsigned short)ix[qq]; } cn[qq] += __popcll(me);
                }
            }
            LDS_WAIT();
#pragma unroll
            for (int qq = 0; qq < 4; ++qq) {
                const unsigned nd = ndq[qq];
                const unsigned Cc = cn[qq] < (unsigned)CAND_CAP ? cn[qq] : (unsigned)CAND_CAP;
                unsigned cqq = cq[qq];
#pragma unroll 1
                for (unsigned base = 0; base < Cc; base += 64) {
                    const unsigned i = base + lane;
                    const unsigned ui = cand_u[qq * CAND_CAP + (i & (CAND_CAP - 1))]; const unsigned ii = cand_i[qq * CAND_CAP + (i & (CAND_CAP - 1))];
                    unsigned rank = 0u;
#pragma unroll 1
                    for (unsigned j = 0; j < Cc; ++j) { const unsigned uj = cand_u[qq * CAND_CAP + j], ij = cand_i[qq * CAND_CAP + j]; rank += ((uj > ui) || (uj == ui && ij < ii)) ? 1u : 0u; }
                    const bool take = (i < Cc) && (rank < nd);
                    const unsigned long long mt = __ballot(take);
                    const unsigned pos = cqq + __popcll(mt & ltm64);
                    if (take && pos < TOPK) sel[qq * 256 + pos] = (unsigned short)ii;
                    cqq += __popcll(mt);
                }
            }
        } else {
            S.prefix0 = 0u; S.prefix1 = 0u; S.need0 = TOPK; S.need1 = TOPK; S.cnt0 = 0u; S.cnt1 = 0u; S.eqt0 = 0u; S.eqt1 = 0u;
#pragma unroll 1
            for (int pass = 0; pass < 4; ++pass) {
                C.shift = 24 - 8 * pass; C.himask = pass ? (0xFFFFFFFFu << (32 - 8 * pass)) : 0u;
                idx_sweep<0>(C, S, ikbuf, ikb, tid, ntile, nchunk, nkeys, sstride);
                LDS_WAIT();
#pragma unroll
                for (int qq = 0; qq < 4; ++qq) {
                    const unsigned nd = (unsigned)__shfl((int)((qq & 1) ? S.need1 : S.need0), (qq >> 1) * 32);
                    int bin; unsigned above, binc;
                    hist_scan(hist + qq * 256, nd, lane, bin, above, binc);
                    if (hh == (qq >> 1)) { if (qq & 1) { S.prefix1 |= (unsigned)bin << C.shift; S.need1 -= above; } else { S.prefix0 |= (unsigned)bin << C.shift; S.need0 -= above; } }
                    const v4u z = {0u, 0u, 0u, 0u}; *(LAS v4u*)(hist + qq * 256 + 4 * lane) = z;
                }
                LDS_WAIT();
            }
            idx_sweep<4>(C, S, ikbuf, ikb, tid, ntile, nchunk, nkeys, sstride);
        }
        LDS_WAIT();
    } else {
#pragma unroll
        for (int qq = 0; qq < 4; ++qq)
#pragma unroll
            for (int i = 0; i < 4; ++i) sel[qq * 256 + lane + 64 * i] = (unsigned short)(lane + 64 * i);
        LDS_WAIT();
    }

    int la_ = lane; asm volatile("" : "+v"(la_));
    const int n16 = la_ & 15, g = la_ >> 4;
#ifdef NO_ATT
    for (int qq = 0; qq < 0; ++qq) {
#else
    for (int repa = 0; repa < 1 + REP_ATT; ++repa)
#pragma unroll 1
    for (int qq = 0; qq < 4; ++qq) {
#endif
        const int tq = tq0 + qq; const int nsel = (tq + 1) < TOPK ? (tq + 1) : TOPK;
        { const v4u qa = *(const v4u*)(projb + (size_t)tq * NPROJ + C_QL + lane * 8), qb = *(const v4u*)(projb + (size_t)tq * NPROJ + C_QL + 512 + lane * 8);
          *(LAS v4u*)((LAS unsigned char*)obuf + lane * 16) = qa; *(LAS v4u*)((LAS unsigned char*)obuf + 1024 + lane * 16) = qb;
          if (lane < 16) *(LAS v4u*)((LAS unsigned char*)obuf + 2048 + lane * 16) = (v4u){0u, 0u, 0u, 0u}; }
        const int qoff = (n16 < 8 ? n16 * 256 : 2048) + 16 * g;
        LDS_WAIT();
        float m_run = -INFINITY, lsum = 0.f;
        f32x4 O[8];
#pragma unroll
        for (int ct = 0; ct < 8; ++ct) O[ct] = (f32x4){0.f, 0.f, 0.f, 0.f};
        const int nch = (nsel + 31) >> 5;
        v4u gvA[8], gvB[8]; f32x4 pqA = {0.f, 0.f, 0.f, 0.f}, pqB = pqA;
#define ATT_LOAD(GV, PQ, cc) do { \
            _Pragma("unroll") for (int it = 0; it < 8; ++it) { const int si = 32 * (cc) + g + 4 * it; const int ki = (si < nsel) ? (int)sel[qq * 256 + si] : 0; GV[it] = *(const v4u*)(ckvb + (size_t)ki * 128 + n16 * 8); } \
            if (lane < 32) { const int si = 32 * (cc) + lane; const int ki = (si < nsel) ? (int)sel[qq * 256 + si] : 0; PQ = *(const f32x4*)(ssqb + (size_t)ki * 4); } } while (0)
#define ATT_CHUNK(GV, PQ, c) do { \
            _Pragma("unroll") for (int it = 0; it < 8; ++it) { const int i = g + 4 * it; *(LAS v4u*)(cbuf + 256 * i + 16 * (n16 ^ swz16(i))) = GV[it]; } \
            if (lane < 32) rsbuf[lane] = 1.0f / sqrtf(((PQ[0] + PQ[1]) + (PQ[2] + PQ[3])) * (1.f / 128.f) + LN_EPS); \
            LDS_WAIT(); \
            if ((c) + 2 < nch) ATT_LOAD(GV, PQ, (c) + 2); \
            f32x4 sc[2]; \
            { bf16x8 bq[4]; \
              _Pragma("unroll") for (int ks = 0; ks < 4; ++ks) bq[ks] = *(LAS bf16x8*)((LAS unsigned char*)obuf + qoff + 64 * ks); \
              _Pragma("unroll") for (int tt = 0; tt < 2; ++tt) { \
                f32x4 a = {0.f, 0.f, 0.f, 0.f}; const int row = 16 * tt + n16; \
                _Pragma("unroll") for (int ks = 0; ks < 4; ++ks) { \
                    const bf16x8 af = *(LAS bf16x8*)(cbuf + 256 * row + 16 * ((4 * ks + g) ^ swz16(row))); \
                    a = __builtin_amdgcn_mfma_f32_16x16x32_bf16(af, bq[ks], a, 0, 0, 0); } \
                sc[tt] = a; __builtin_amdgcn_sched_barrier(0); } } \
            f32x4 rsv[2]; rsv[0] = *(LAS f32x4*)(rsbuf + 4 * g); rsv[1] = *(LAS f32x4*)(rsbuf + 16 + 4 * g); \
            float cmax = -INFINITY; \
            _Pragma("unroll") for (int tt = 0; tt < 2; ++tt) _Pragma("unroll") for (int r = 0; r < 4; ++r) { float s = sc[tt][r] * rsv[tt][r]; if (32 * (c) + 16 * tt + 4 * g + r >= nsel) s = -INFINITY; sc[tt][r] = s; cmax = fmaxf(cmax, s); } \
            if (__any(cmax > m_run + 8.0f)) {     \
                cmax = fmaxf(cmax, __shfl_xor(cmax, 16)); cmax = fmaxf(cmax, __shfl_xor(cmax, 32)); \
                const float mnew = fmaxf(m_run, cmax); const float alpha = __expf(m_run - mnew); \
                lsum *= alpha; m_run = mnew; \
                float ar[4]; _Pragma("unroll") for (int r = 0; r < 4; ++r) ar[r] = __shfl(alpha, 4 * g + r); \
                _Pragma("unroll") for (int ct = 0; ct < 8; ++ct) { O[ct][0] *= ar[0]; O[ct][1] *= ar[1]; O[ct][2] *= ar[2]; O[ct][3] *= ar[3]; } } \
            float psum = 0.f; float pp[2][4]; \
            _Pragma("unroll") for (int tt = 0; tt < 2; ++tt) _Pragma("unroll") for (int r = 0; r < 4; ++r) { const float p = __expf(sc[tt][r] - m_run); psum += p; pp[tt][r] = p * rsv[tt][r]; } \
            lsum += psum; \
            bf16x8 PA; { v4u pw; pw.x = pk2(pp[0][0], pp[0][1]); pw.y = pk2(pp[0][2], pp[0][3]); pw.z = pk2(pp[1][0], pp[1][1]); pw.w = pk2(pp[1][2], pp[1][3]); PA = __builtin_bit_cast(bf16x8, pw); } \
            { const int qrow = (n16 >> 2), p4 = n16 & 3; const int rlo = 4 * g + qrow, rhi = 16 + 4 * g + qrow; \
              _Pragma("unroll") for (int ct = 0; ct < 8; ++ct) { const int ch = 2 * ct + (p4 >> 1); \
                  const s16x4 lo = __builtin_bit_cast(s16x4, __builtin_amdgcn_ds_read_tr16_b64_v4i16((LAS s16x4*)(cbuf + 256 * rlo + 16 * (ch ^ swz16(rlo)) + 8 * (p4 & 1)))); \
                  const s16x4 hi = __builtin_bit_cast(s16x4, __builtin_amdgcn_ds_read_tr16_b64_v4i16((LAS s16x4*)(cbuf + 256 * rhi + 16 * (ch ^ swz16(rhi)) + 8 * (p4 & 1)))); \
                  const bf16x8 vf = {lo[0], lo[1], lo[2], lo[3], hi[0], hi[1], hi[2], hi[3]}; \
                  O[ct] = __builtin_amdgcn_mfma_f32_16x16x32_bf16(PA, vf, O[ct], 0, 0, 0); if ((ct & 1) == 1) __builtin_amdgcn_sched_barrier(0); } } \
            LDS_WAIT(); asm volatile("" ::: "memory"); } while (0)
        ATT_LOAD(gvA, pqA, 0);
        if (nch > 1) ATT_LOAD(gvB, pqB, 1);
#pragma unroll 1
        for (int c = 0; c < nch; c += 2) {
            ATT_CHUNK(gvA, pqA, c);
            if (c + 1 < nch) ATT_CHUNK(gvB, pqB, c + 1);
        }
#undef ATT_LOAD
#undef ATT_CHUNK
        float ltot = lsum; ltot += __shfl_xor(ltot, 16); ltot += __shfl_xor(ltot, 32);
        const float inv = 1.0f / ltot;
        float ir[4];
#pragma unroll
        for (int r = 0; r < 4; ++r) ir[r] = __shfl(inv, 4 * g + r);
        if (g < 2) {
#pragma unroll
            for (int ct = 0; ct < 8; ++ct)
#pragma unroll
                for (int r = 0; r < 4; ++r) obuf[(4 * g + r) * 128 + 16 * ct + n16] = (bf16_t)f2bf(O[ct][r] * ir[r]);
        }
        LDS_WAIT();
        { bf16_t* dst = P.ymix + (size_t)(b * SEQ + tq) * KMIX;
#pragma unroll
          for (int k = 0; k < 2; ++k) { const int piece = lane + 64 * k; *(v4u*)(dst + piece * 8) = *(LAS v4u*)((LAS unsigned char*)obuf + piece * 16); } }
        LDS_WAIT();
        asm volatile("" ::: "memory");
    }
    __syncthreads();
}

#ifndef REP_CP
#define REP_CP 0
#endif
#ifndef REP_DSA
#define REP_DSA 0
#endif
__device__ __forceinline__ void phase_mixers(const Frame& F0, int l) {
    const Frame F = relaunder(F0);
    KArgs A = kargs();
    MixP P;
    P.rec = (unsigned*)(A->ws + WS_REC); P.proj = ws_bf(A, WS_PROJ); P.ikc = ws_bf(A, WS_IKC); P.ckvc = ws_bf(A, WS_CKVC); P.ymix = ws_bf(A, WS_YMIX); P.ssq = (const float*)(A->ws + WS_SSQ);
    P.wpt = ws_bf(A, WS_WPT); P.pool_scale = A->in[6] + l * 256; P.conv_w = A->in[7] + (size_t)l * 31 * 256; P.conv_b = A->in[8] + l * 256;
    P.cln_g = A->in[9] + l * 256; P.cln_b = A->in[10] + l * 256;
#ifndef NO_CONVPOOL
#pragma unroll 1
    for (int rep = 0; rep < 1 + REP_CP; ++rep)
#pragma unroll 1
    for (int tile = F.bid; tile < M / 32; tile += F.G) conv_pool_tile(F, P, tile);
#endif
    __syncthreads();
#pragma unroll 1
    for (int rep = 0; rep < 1 + REP_DSA; ++rep)
#pragma unroll 1
    for (int it = F.bid; it < 512; it += F.G) {
        const int b = it >> 8, gi = it & 255; const int grp = b ? (255 - gi) : gi;
#ifndef NO_DSA
        dsa_group(F, P, b, grp * 32);
#endif
    }
    __syncthreads();
}

__device__ __forceinline__ float top2sum4(float a, float b, float c, float d) {
    const float hi1 = fmaxf(a, b), lo1 = fminf(a, b), hi2 = fmaxf(c, d), lo2 = fminf(c, d);
    const float top = fmaxf(hi1, hi2), second = fmaxf(fminf(hi1, hi2), (hi1 >= hi2) ? lo1 : lo2);
    return top + second;
}
__device__ __forceinline__ void phase_ln1_router(const Frame& F0, int l) {
    const Frame F = relaunder(F0);
    KArgs A = kargs();
    float* out = A->out; bf16_t* xb = ws_bf(A, WS_XB);
    const float* ln1_g = A->in[12] + l * DM; const float* ln1_b = A->in[13] + l * DM; const float* router_w = A->in[14]; const float* router_b = A->in[15];
    int* toke = (int*)(A->ws + WS_TOKE); float* tokg = (float*)(A->ws + WS_TOKG); unsigned* blkcnt = (unsigned*)(A->ws + WS_BLKCNT);
    const int lane = F.lane, wave = F.wave;
    LAS float* xs = (LAS float*)(F.lds + wave * 4096);
    LAS unsigned* cnt = (LAS unsigned*)(F.lds + LDS_MISC + 512);
    if (F.tid < 16) cnt[F.tid] = 0u;
    __syncthreads();
    const int e16 = lane & 15, qr = lane >> 4;
    const float bias_e = router_b[e16];
#pragma unroll 1
    for (int i = 0; i < 8; ++i) {
        const int row = F.bid * 64 + wave * 8 + i;
        float* vr = out + (size_t)row * DM;
        f32x4 v[4]; float s = 0.f;
#pragma unroll
        for (int j = 0; j < 4; ++j) { v[j] = *(const f32x4*)(vr + 4 * lane + 256 * j); s += (v[j][0] + v[j][1]) + (v[j][2] + v[j][3]); }
        const float mean = wave_sum(s) * (1.f / DM); float s2 = 0.f;
#pragma unroll
        for (int j = 0; j < 4; ++j) { v[j] = v[j] - mean; s2 += (v[j][0] * v[j][0] + v[j][1] * v[j][1]) + (v[j][2] * v[j][2] + v[j][3] * v[j][3]); }
        const float rstd = 1.0f / sqrtf(wave_sum(s2) * (1.f / DM) + LN_EPS);
#pragma unroll
        for (int j = 0; j < 4; ++j) {
            const f32x4 g = *(const f32x4*)(ln1_g + 4 * lane + 256 * j), b = *(const f32x4*)(ln1_b + 4 * lane + 256 * j);
            const f32x4 y = v[j] * rstd * g + b;
            *(f32x4*)(vr + 4 * lane + 256 * j) = y;
            v2u w; w.x = pk2(y[0], y[1]); w.y = pk2(y[2], y[3]); *(v2u*)(xb + (size_t)row * DM + 4 * lane + 256 * j) = w;
            *(LAS f32x4*)(xs + 4 * lane + 256 * j) = y;
        }
        LDS_WAIT();
        float acc = 0.f;
        { const float* rw = router_w + (size_t)(qr * 256) * NE + e16; const LAS float* xq = xs + qr * 256;
#pragma unroll 8
          for (int c = 0; c < 256; ++c) acc += xq[c] * rw[c * NE]; }
        acc += __shfl_xor(acc, 16); acc += __shfl_xor(acc, 32);
        const float aff = sigmoidf_(acc), scv = aff + bias_e;
        float sv[16];
#pragma unroll
        for (int k = 0; k < 16; ++k) sv[k] = __shfl(scv, k);
        float gs[4];
#pragma unroll
        for (int gq = 0; gq < 4; ++gq) gs[gq] = top2sum4(sv[4 * gq], sv[4 * gq + 1], sv[4 * gq + 2], sv[4 * gq + 3]);
        int best = 0; float bv = gs[0];
#pragma unroll
        for (int gq = 1; gq < 4; ++gq) if (gs[gq] > bv) { bv = gs[gq]; best = gq; }
        float c0 = sv[0], c1 = sv[1], c2 = sv[2], c3 = sv[3];
#pragma unroll
        for (int gq = 1; gq < 4; ++gq) if (best == gq) { c0 = sv[4 * gq]; c1 = sv[4 * gq + 1]; c2 = sv[4 * gq + 2]; c3 = sv[4 * gq + 3]; }
        int i1 = 0; float m1 = c0;
        if (c1 > m1) { m1 = c1; i1 = 1; } if (c2 > m1) { m1 = c2; i1 = 2; } if (c3 > m1) { m1 = c3; i1 = 3; }
        int i2 = -1; float m2 = -INFINITY;
        if (i1 != 0 && c0 > m2) { m2 = c0; i2 = 0; } if (i1 != 1 && c1 > m2) { m2 = c1; i2 = 1; } if (i1 != 2 && c2 > m2) { m2 = c2; i2 = 2; } if (i1 != 3 && c3 > m2) { m2 = c3; i2 = 3; }
        if (i2 < 0) i2 = (i1 == 0) ? 1 : 0;
        const int e1 = 4 * best + i1, e2 = 4 * best + i2;
        const float a1 = __shfl(aff, e1), a2 = __shfl(aff, e2);
        const float den = a1 + a2;
        if (lane == 0) {
            toke[row * 2] = e1; toke[row * 2 + 1] = e2; tokg[row * 2] = a1 / den; tokg[row * 2 + 1] = a2 / den;
            __hip_atomic_fetch_add(cnt + e1, 1u, __ATOMIC_RELAXED, __HIP_MEMORY_SCOPE_WORKGROUP);
            __hip_atomic_fetch_add(cnt + e2, 1u, __ATOMIC_RELAXED, __HIP_MEMORY_SCOPE_WORKGROUP);
        }
        LDS_WAIT();
    }
    __syncthreads();
    if (F.tid < 16) blkcnt[F.bid * 16 + F.tid] = cnt[F.tid];
}

__device__ __forceinline__ void phase_route(const Frame& F0) {
    const Frame F = relaunder(F0);
    KArgs A = kargs();
    const bf16_t* xb = ws_bf(A, WS_XB); bf16_t* xs = ws_bf(A, WS_XS);
    const int* toke = (const int*)(A->ws + WS_TOKE); const float* tokg = (const float*)(A->ws + WS_TOKG); int* toks = (int*)(A->ws + WS_TOKS);
    float* gslot = (float*)(A->ws + WS_GSLOT); int* tiletab = (int*)(A->ws + WS_TILETAB); const unsigned* blkcnt = (const unsigned*)(A->ws + WS_BLKCNT);
    const int lane = F.lane, wave = F.wave;
    LAS int* slots = (LAS int*)(F.lds + LDS_MISC + 1024);
    if (wave == 0) {
        const int e = lane & 15, part = lane >> 4;
        unsigned tot = 0u, pre = 0u;
#pragma unroll 16
        for (int bb = part; bb < F.G; bb += 4) { const unsigned c = blkcnt[bb * 16 + e]; tot += c; if (bb < F.bid) pre += c; }
        tot += __shfl_xor((int)tot, 16); tot += __shfl_xor((int)tot, 32);
        pre += __shfl_xor((int)pre, 16); pre += __shfl_xor((int)pre, 32);
        const unsigned padded = (tot + 255u) & ~255u;
        unsigned off = 0u, total_pad = 0u;
#pragma unroll
        for (int k = 0; k < 16; ++k) { const unsigned pk = (unsigned)__shfl((int)padded, k); if (k < e) off += pk; total_pad += pk; }
        unsigned base = off + pre;
        const int myrow = F.bid * 64 + lane;
        const int me1 = ld_agent(toke + myrow * 2), me2 = ld_agent(toke + myrow * 2 + 1);
        const float mg1 = ld_agent_f(tokg + myrow * 2), mg2 = ld_agent_f(tokg + myrow * 2 + 1);
        unsigned ms1 = 0u, ms2 = 0u;
#pragma unroll 1
        for (int i = 0; i < 64; ++i) {
            const int e1 = __shfl(me1, i), e2 = __shfl(me2, i);
            const unsigned s1 = (unsigned)__shfl((int)base, e1); base += (e == e1) ? 1u : 0u;
            const unsigned s2 = (unsigned)__shfl((int)base, e2); base += (e == e2) ? 1u : 0u;
            if (lane == i) { ms1 = s1; ms2 = s2; }
        }
        slots[2 * lane] = (int)ms1; slots[2 * lane + 1] = (int)ms2; toks[myrow * 2] = (int)ms1; toks[myrow * 2 + 1] = (int)ms2;
        gslot[ms1] = mg1; gslot[ms2] = mg2;
        if (F.bid == 0) {
            const int ntile = (int)(total_pad >> 8);
            if (lane == 0) tiletab[0] = ntile;
            for (int t = lane; t < ntile; t += 64) {
                int ex = 0;
#pragma unroll
                for (int k = 0; k < 16; ++k) { const unsigned ok = (unsigned)__shfl((int)off, k); if ((unsigned)(t * 256) >= ok) ex = k; }
                tiletab[1 + t] = ex;
            }
#pragma unroll
            for (int k = 0; k < 16; ++k) {
                const unsigned ok = (unsigned)__shfl((int)off, k), tk = (unsigned)__shfl((int)tot, k), pk = (unsigned)__shfl((int)padded, k);
                for (unsigned s = ok + tk + lane; s < ok + pk; s += 64) gslot[s] = 0.f;
            }
        }
    }
    LDS_WAIT();
    __syncthreads();
#pragma unroll 1
    for (int i = 0; i < 8; ++i) {
        const int ti = wave * 8 + i, row = F.bid * 64 + ti;
        const v4u a = *(const v4u*)(xb + (size_t)row * DM + lane * 8), b = *(const v4u*)(xb + (size_t)row * DM + 512 + lane * 8);
#pragma unroll
        for (int k = 0; k < 2; ++k) { const int s = slots[2 * ti + k]; bf16_t* d = xs + (size_t)s * DM; *(v4u*)(d + lane * 8) = a; *(v4u*)(d + 512 + lane * 8) = b; }
    }
}

__device__ __forceinline__ void phase_ln2(const Frame& F0, int l) {
    const Frame F = relaunder(F0);
    KArgs A = kargs();
    float* out = A->out; bf16_t* xb = ws_bf(A, WS_XB); const int* toks = (const int*)(A->ws + WS_TOKS);
    const float* ln2_g = A->in[19] + l * DM; const float* ln2_b = A->in[20] + l * DM;
    const int lane = F.lane, wave = F.wave;
    const bf16_t* Y = ws_bf(A, WS_XS);
#pragma unroll 1
    for (int i = 0; i < 8; ++i) {
        const int row = F.bid * 64 + wave * 8 + i;
        const int s0 = ld_agent(toks + row * 2), s1 = ld_agent(toks + row * 2 + 1);
        float* vr = out + (size_t)row * DM;
        f32x4 v[4]; float s = 0.f;
#pragma unroll
        for (int j = 0; j < 4; ++j) {
            const f32x4 x = *(const f32x4*)(vr + 4 * lane + 256 * j);
            const v2u y0 = *(const v2u*)(Y + (size_t)s0 * DM + 4 * lane + 256 * j), y1 = *(const v2u*)(Y + (size_t)s1 * DM + 4 * lane + 256 * j);
            f32x4 f; f[0] = bflo(y0.x) + bflo(y1.x); f[1] = bfhi(y0.x) + bfhi(y1.x); f[2] = bflo(y0.y) + bflo(y1.y); f[3] = bfhi(y0.y) + bfhi(y1.y);
            v[j] = x * ALPHA + f; s += (v[j][0] + v[j][1]) + (v[j][2] + v[j][3]);
        }
        const float mean = wave_sum(s) * (1.f / DM); float s2 = 0.f;
#pragma unroll
        for (int j = 0; j < 4; ++j) { v[j] = v[j] - mean; s2 += (v[j][0] * v[j][0] + v[j][1] * v[j][1]) + (v[j][2] * v[j][2] + v[j][3] * v[j][3]); }
        const float rstd = 1.0f / sqrtf(wave_sum(s2) * (1.f / DM) + LN_EPS);
#pragma unroll
        for (int j = 0; j < 4; ++j) {
            const f32x4 g = *(const f32x4*)(ln2_g + 4 * lane + 256 * j), b = *(const f32x4*)(ln2_b + 4 * lane + 256 * j);
            const f32x4 y = v[j] * rstd * g + b;
            *(f32x4*)(vr + 4 * lane + 256 * j) = y;
            v2u w; w.x = pk2(y[0], y[1]); w.y = pk2(y[2], y[3]); *(v2u*)(xb + (size_t)row * DM + 4 * lane + 256 * j) = w;
        }
    }
}

constexpr int N_PHASES = 17;

__global__ void __launch_bounds__(NTHR, 2) fwd_kernel(Args args) {
    extern __shared__ __attribute__((aligned(16))) unsigned char lds_raw[];
    cg::grid_group grid = cg::this_grid();
    Frame F;
    F.lds = (LAS unsigned char*)lds_raw;
    F.tid = threadIdx.x; F.lane = F.tid & 63; F.wave = __builtin_amdgcn_readfirstlane(F.tid >> 6);
    F.G = gridDim.x; F.bid = blockIdx.x;
    const int lo = args.ph_lo, hi = args.ph_hi, coop = args.coop;
    if (F.tid < 32) ((LAS unsigned*)(F.lds + LDS_MISC))[F.tid] = 0u;
    __syncthreads();
    XcdBarrier bar; bar.bar = nullptr; bar.x = 0; bar.st = nullptr;
    if (coop) bar = xcd_barrier_post((unsigned*)(kargs()->ws + WS_BAR), (volatile LAS unsigned*)(F.lds + LDS_MISC) + 8);
#ifndef PHMASK
#define PHMASK 0x1ff
#endif
#define IN(k) (lo <= (k) && (k) < hi)
#define EN(b) ((PHMASK >> (b)) & 1)
#ifndef REPMASK
#define REPMASK 0
#endif
#define NREP(b) (1 + ((REPMASK >> (b)) & 1))
#define SEAM(k) do { if (IN(k) && IN((k) + 1)) { if (coop) { if ((k) == 0) grid.sync(); else xcd_barrier(bar); } } } while (0)

    if (EN(0) && IN(0)) for (int rep = 0; rep < NREP(0); ++rep) { if (rep) xcd_barrier(bar); phase_convert(F, 0, true, 0); }
    SEAM(0);
#pragma unroll 1
    for (int l = 0; l < 2; ++l) {
        const int pb = 1 + 8 * l;
        if (EN(1) && IN(pb + 0)) for (int rep = 0; rep < NREP(1); ++rep) {
            if (rep) xcd_barrier(bar);
            KArgs A = kargs();
            pg8::Gemm g{ws_bf(A, WS_XB), ws_bf(A, WS_WIN), M, NPROJ, DM}; pg8::StaticOrder S; S.init(M, NPROJ, F.G, F.bid);
            EpiProj E{ws_bf(A, WS_PROJ), (float*)(A->ws + WS_SSQ), ws_bf(A, WS_IKC), ws_bf(A, WS_CKVC)};
            pg8::gemm_phase<EpiProj, pg8::StaticOrder, true, true>(F.lds, g, S, E);
        }
        SEAM(pb + 0);
        if (EN(2) && IN(pb + 1)) for (int rep = 0; rep < NREP(2); ++rep) { if (rep) xcd_barrier(bar); phase_mixers(F, l); }
        SEAM(pb + 1);
        if (EN(3) && IN(pb + 2)) {
            KArgs A = kargs();
            pg8::Gemm g{ws_bf(A, WS_YMIX), ws_bf(A, WS_WO), M, DM, KMIX}; pg8::StaticOrder S; S.init(M, DM, F.G, F.bid);
            EpiMix E{l == 0 ? A->in[0] : (const float*)A->out, A->out};
            pg8::gemm_phase<EpiMix, pg8::StaticOrder, true, true>(F.lds, g, S, E);
        }
        SEAM(pb + 2);
        if (EN(4) && IN(pb + 3)) { phase_ln1_router(F, l); __syncthreads(); phase_convert(F, l, false, 1); }
        SEAM(pb + 3);
        if (EN(5) && IN(pb + 4)) for (int rep = 0; rep < NREP(5); ++rep) { if (rep) xcd_barrier(bar); phase_route(F); }
        SEAM(pb + 4);
        if (EN(6) && IN(pb + 5)) for (int rep = 0; rep < NREP(6); ++rep) {
            if (rep) xcd_barrier(bar);
            KArgs A = kargs();
            pg8::Gemm g{ws_bf(A, WS_XS), ws_bf(A, WS_WGU), MAXSLOT, NE * 1024, DM}; GroupedOrder S; S.init((const int*)(A->ws + WS_TILETAB), F.G, F.bid);
            EpiGU E{ws_bf(A, WS_H), (const float*)(A->ws + WS_GSLOT)};
            pg8::gemm_phase<EpiGU, GroupedOrder, true, true>(F.lds, g, S, E);
        }
        SEAM(pb + 5);
        if (EN(7) && IN(pb + 6)) for (int rep = 0; rep < NREP(7); ++rep) {
            if (rep) xcd_barrier(bar);
            KArgs A = kargs();
            pg8::Gemm g{ws_bf(A, WS_H), ws_bf(A, WS_WD), MAXSLOT, NE * 1024, DE}; GroupedOrder S; S.init((const int*)(A->ws + WS_TILETAB), F.G, F.bid);
            EpiDown E{ws_bf(A, WS_XS)};
            pg8::gemm_phase<EpiDown, GroupedOrder, true, true>(F.lds, g, S, E);
        }
        SEAM(pb + 6);
        if (EN(8) && IN(pb + 7)) {
            phase_ln2(F, l);
            if (l == 0) { __syncthreads(); phase_convert(F, 1, false, 0); }
        }
        if (l == 0) SEAM(pb + 7);
    }
#undef IN
#undef SEAM
}

#ifndef MK_N_LAUNCHES
#define MK_N_LAUNCHES 1
#endif

extern "C" void kernel_launch(void* const* d_in, const int* in_sizes, int n_in, void* d_out, int out_size, void* d_ws, size_t ws_size, hipStream_t stream) {
    static int grid = 0;
    if (grid == 0) {
        int dev = 0, cus = 0, per_cu = 0;
        if (n_in != 21 || out_size != M * DM || ws_size < WS_END) { fprintf(stderr, "kernel_launch: unexpected problem (n_in %d out %d ws %zu)\n", n_in, out_size, ws_size); grid = -1; return; }
        if (hipGetDevice(&dev) != hipSuccess || hipDeviceGetAttribute(&cus, hipDeviceAttributeMultiprocessorCount, dev) != hipSuccess) { grid = -1; return; }
        if (hipFuncSetAttribute((const void*)fwd_kernel, hipFuncAttributeMaxDynamicSharedMemorySize, LDS_BYTES) != hipSuccess) { fprintf(stderr, "kernel_launch: hipFuncSetAttribute failed\n"); grid = -1; return; }
        if (hipOccupancyMaxActiveBlocksPerMultiprocessor(&per_cu, (const void*)fwd_kernel, NTHR, LDS_BYTES) != hipSuccess || per_cu < 1) { fprintf(stderr, "kernel_launch: occupancy query says %d\n", per_cu); grid = -1; (void)hipGetLastError(); return; }
        grid = cus;
        if (grid != 256) { fprintf(stderr, "kernel_launch: built for 256 CUs, found %d\n", cus); grid = -1; return; }
    }
    if (grid < 0) return;
    if (hipMemsetAsync((char*)d_ws + WS_BAR, 0, 16384, stream) != hipSuccess) { fprintf(stderr, "kernel_launch: memset failed\n"); return; }
    Args a{};
    for (int i = 0; i < 21; ++i) a.in[i] = (const float*)d_in[i];
    a.out = (float*)d_out; a.ws = (unsigned char*)d_ws; a.pad = 0;
#if MK_N_LAUNCHES == 1
    a.ph_lo = 0; a.ph_hi = N_PHASES; a.coop = 1;
    void* kargs[] = {&a};
    hipError_t e = hipLaunchCooperativeKernel((const void*)fwd_kernel, dim3(grid), dim3(NTHR), kargs, LDS_BYTES, stream);
    if (e != hipSuccess) fprintf(stderr, "kernel_launch: cooperative launch failed: %s\n", hipGetErrorString(e));
#else
    for (int p = 0; p < N_PHASES; ++p) {
        a.ph_lo = p; a.ph_hi = p + 1; a.coop = 0;
        hipLaunchKernelGGL(fwd_kernel, dim3(grid), dim3(NTHR), LDS_BYTES, stream, a);
    }
#endif
}
```
